# Optimizing an MI355X kernel written in HIP

```python
import math
import jax, jax.numpy as jnp
from jax import lax
import numpy as np

D_MODEL = 1024
BATCH = 2
SEQ = 8192
DEPTH = 2

MEM_LEN = 256
D_MIX = D_MODEL
SSD_WIDTH = D_MIX // 2
SSD_HEAD_DIM = 64
SSD_HEADS = SSD_WIDTH // SSD_HEAD_DIM
SSD_GROUPS = 2
SSD_HEADS_PER_GROUP = SSD_HEADS // SSD_GROUPS
SSD_STATE = 128
SSD_CONV = 4
SSD_CHUNK = 128
SSD_XBC = SSD_WIDTH + 2 * SSD_GROUPS * SSD_STATE

S5_WIDTH = D_MIX // 4
S5_GROUP_CH = 16
S5_GROUPS = S5_WIDTH // S5_GROUP_CH
S5_STATE = 64

RG_WIDTH = D_MIX - SSD_WIDTH - S5_WIDTH
RG_BLOCKS = 4
RG_BLOCK_DIM = RG_WIDTH // RG_BLOCKS
RG_CONV = 4
RG_C = 8.0

XA_HEADS = 4
XA_HEAD_DIM = D_MODEL // XA_HEADS
D_FF = 4 * D_MODEL

ALPHA = (2.0 * DEPTH) ** 0.25
BETA = (8.0 * DEPTH) ** -0.25
LN_EPS = 1e-5

IN_COLS = (SSD_WIDTH, SSD_XBC, SSD_HEADS, S5_WIDTH, RG_WIDTH, RG_WIDTH)
D_IN = SSD_WIDTH + SSD_XBC + SSD_HEADS + S5_WIDTH + RG_WIDTH + RG_WIDTH

kernel_name = "hybrid_ssd_s5_rglru_deepnorm"


def layer_norm(x, g, b):
    x32 = x.astype(jnp.float32)
    mu = jnp.mean(x32, axis=-1, keepdims=True)
    var = jnp.mean(jnp.square(x32 - mu), axis=-1, keepdims=True)
    return (x32 - mu) * lax.rsqrt(var + LN_EPS) * g.astype(jnp.float32) + b.astype(jnp.float32)


def causal_dwconv(x, w, b):
    k, c = w.shape
    y = lax.conv_general_dilated(x, w[:, None, :].astype(x.dtype), window_strides=(1,),
                                 padding=[(k - 1, 0)], dimension_numbers=('NWC', 'WIO', 'NWC'),
                                 feature_group_count=c)
    return y + b.astype(x.dtype)


def _lin_combine(left, right):
    a1, b1 = left
    a2, b2 = right
    return a1 * a2, a2 * b1 + b2


def linear_scan(a, b):
    return lax.associative_scan(_lin_combine, (a, b), axis=1)[1]


def ssd_mixer(z, xbc, dt_raw, conv_w, conv_b, dt_bias, a_log, d_skip, norm_w):
    bsz, seq, _ = z.shape
    nc = seq // SSD_CHUNK
    xbc = jax.nn.silu(causal_dwconv(xbc, conv_w.astype(jnp.float32), conv_b.astype(jnp.float32)))
    xs = xbc[..., :SSD_WIDTH]
    bm = xbc[..., SSD_WIDTH:SSD_WIDTH + SSD_GROUPS * SSD_STATE]
    cm = xbc[..., SSD_WIDTH + SSD_GROUPS * SSD_STATE:]
    dt = jax.nn.softplus(dt_raw + dt_bias.astype(jnp.float32))
    a = -jnp.exp(a_log.astype(jnp.float32))
    g, hg, p, n, q = SSD_GROUPS, SSD_HEADS_PER_GROUP, SSD_HEAD_DIM, SSD_STATE, SSD_CHUNK
    xh = xs.reshape(bsz, seq, SSD_HEADS, p)
    xdt = (xh * dt[..., None]).reshape(bsz, nc, q, g, hg, p)
    adt = (dt * a).reshape(bsz, nc, q, g, hg).transpose(0, 1, 3, 4, 2)
    bc = bm.reshape(bsz, nc, q, g, n)
    cc = cm.reshape(bsz, nc, q, g, n)
    a_cs = jnp.cumsum(adt, axis=-1)
    mask = jnp.tril(jnp.ones((q, q), dtype=bool))
    seg = a_cs[..., :, None] - a_cs[..., None, :]
    lmat = jnp.exp(jnp.where(mask, seg, -jnp.inf))
    cb = jnp.einsum('bclgn,bcsgn->bcgls', cc, bc)
    y_diag = jnp.einsum('bcgls,bcghls,bcsghp->bclghp', cb, lmat, xdt)
    decay_states = jnp.exp(a_cs[..., -1:] - a_cs)
    states = jnp.einsum('bclgn,bcghl,bclghp->bcghpn', bc, decay_states, xdt)
    chunk_decay = jnp.exp(a_cs[..., -1])

    def step(s, inp):
        st, dec = inp
        return s * dec[..., None, None] + st, s

    init = jnp.zeros((bsz, g, hg, p, n), jnp.float32)
    _, prev = lax.scan(step, init, (jnp.moveaxis(states, 1, 0), jnp.moveaxis(chunk_decay, 1, 0)))
    prev = jnp.moveaxis(prev, 0, 1)
    y_off = jnp.einsum('bclgn,bcghpn,bcghl->bclghp', cc, prev, jnp.exp(a_cs))
    y = (y_diag + y_off).reshape(bsz, seq, SSD_HEADS, p) + xh * d_skip.astype(jnp.float32)[:, None]
    y = y.reshape(bsz, seq, SSD_WIDTH) * jax.nn.silu(z)
    y = y * lax.rsqrt(jnp.mean(jnp.square(y), axis=-1, keepdims=True) + LN_EPS)
    return y * norm_w.astype(jnp.float32)


def s5_mixer(u, lam_re, lam_im, log_step, b_re, b_im, c_re, c_im, d_skip, glu_w, glu_b):
    bsz, seq, _ = u.shape
    f32 = jnp.float32
    ug = u.reshape(bsz, seq, S5_GROUPS, S5_GROUP_CH).astype(jnp.complex64)
    lam = lax.complex(lam_re.astype(f32), lam_im.astype(f32))
    step = jnp.exp(log_step.astype(f32))[:, None]
    lam_bar = jnp.exp(lam * step)
    bmat = lax.complex(b_re.astype(f32), b_im.astype(f32))
    b_bar = ((lam_bar - 1.0) / lam)[..., None] * bmat
    bu = jnp.einsum('gpc,blgc->blgp', b_bar, ug)
    h = linear_scan(jnp.broadcast_to(lam_bar, bu.shape), bu)
    cmat = lax.complex(c_re.astype(f32), c_im.astype(f32))
    y = jnp.real(jnp.einsum('gcp,blgp->blgc', cmat, h)).reshape(bsz, seq, S5_WIDTH)
    y = jax.nn.gelu(y + d_skip.astype(f32) * u)
    return y * jax.nn.sigmoid(jnp.einsum('blc,ce->ble', y, glu_w.astype(f32)) + glu_b.astype(f32))


def rglru_mixer(xr, gate_in, conv_w, conv_b, wa, ba, wx, bx, lam):
    bsz, seq, _ = xr.shape
    f32 = jnp.float32
    xc = causal_dwconv(xr, conv_w.astype(f32), conv_b.astype(f32))
    xh = xc.reshape(bsz, seq, RG_BLOCKS, RG_BLOCK_DIM)
    r = jax.nn.sigmoid(jnp.einsum('blhi,hij->blhj', xh, wa.astype(f32)) + ba.astype(f32)).reshape(bsz, seq, RG_WIDTH)
    i = jax.nn.sigmoid(jnp.einsum('blhi,hij->blhj', xh, wx.astype(f32)) + bx.astype(f32)).reshape(bsz, seq, RG_WIDTH)
    log_a = -RG_C * r * jax.nn.softplus(-lam.astype(f32))
    a = jnp.exp(log_a)
    mult = jnp.sqrt(-jnp.expm1(2.0 * log_a))
    h = linear_scan(a, mult * (i * xc))
    return h * jax.nn.gelu(gate_in)


def cross_attention(x, mem, wq, wk, wv, wo):
    bsz, seq, _ = x.shape
    f32 = jnp.float32
    q = jnp.einsum('bld,de->ble', x, wq.astype(f32)).reshape(bsz, seq, XA_HEADS, XA_HEAD_DIM)
    k = jnp.einsum('bmd,de->bme', mem, wk.astype(f32)).reshape(bsz, -1, XA_HEADS, XA_HEAD_DIM)
    v = jnp.einsum('bmd,de->bme', mem, wv.astype(f32)).reshape(bsz, -1, XA_HEADS, XA_HEAD_DIM)
    s = jnp.einsum('blhd,bmhd->bhlm', q, k) * (1.0 / math.sqrt(XA_HEAD_DIM))
    pr = jax.nn.softmax(s, axis=-1)
    o = jnp.einsum('bhlm,bmhd->blhd', pr, v).reshape(bsz, seq, D_MODEL)
    return jnp.einsum('ble,ed->bld', o, wo.astype(f32))


def squared_relu_mlp(x, w1, w2):
    hdn = jnp.square(jax.nn.relu(jnp.einsum('bld,df->blf', x, w1.astype(jnp.float32))))
    return jnp.einsum('blf,fd->bld', hdn, w2.astype(jnp.float32))


def setup_inputs(seed: int = 0) -> dict:
    key = jax.random.key(seed)
    ks = iter(jax.random.split(key, 64))
    f32 = jnp.float32

    def nrm(shape, scale):
        return jax.random.normal(next(ks), shape, f32) * scale

    def uni(shape, lo, hi):
        return jax.random.uniform(next(ks), shape, f32, lo, hi)

    L = DEPTH
    x = nrm((BATCH, SEQ, D_MODEL), 1.0)
    mem = nrm((BATCH, MEM_LEN, D_MODEL), 1.0)
    dt0 = jnp.exp(uni((L, SSD_HEADS), math.log(1e-3), math.log(1e-1)))
    a_rg = uni((L, RG_WIDTH), 0.9, 0.999) ** (1.0 / RG_C)
    n_idx = jnp.arange(S5_STATE, dtype=f32)
    return {
        "x": x,
        "mem": mem,
        "w_in": nrm((L, D_MODEL, D_IN), D_MODEL ** -0.5),
        "w_out": nrm((L, D_MIX, D_MODEL), BETA * D_MIX ** -0.5),
        "ssd_conv_w": nrm((L, SSD_CONV, SSD_XBC), SSD_CONV ** -0.5),
        "ssd_conv_b": nrm((L, SSD_XBC), 0.02),
        "ssd_dt_bias": dt0 + jnp.log(-jnp.expm1(-dt0)),
        "ssd_a_log": jnp.log(uni((L, SSD_HEADS), 1.0, 16.0)),
        "ssd_d": 1.0 + nrm((L, SSD_HEADS), 0.02),
        "ssd_norm_w": 1.0 + nrm((L, SSD_WIDTH), 0.02),
        "s5_lam_re": -0.5 + nrm((L, S5_GROUPS, S5_STATE), 0.01),
        "s5_lam_im": jnp.pi * n_idx + nrm((L, S5_GROUPS, S5_STATE), 0.01),
        "s5_log_step": uni((L, S5_GROUPS), math.log(1e-3), math.log(1e-1)),
        "s5_b_re": nrm((L, S5_GROUPS, S5_STATE, S5_GROUP_CH), (2.0 * S5_GROUP_CH) ** -0.5),
        "s5_b_im": nrm((L, S5_GROUPS, S5_STATE, S5_GROUP_CH), (2.0 * S5_GROUP_CH) ** -0.5),
        "s5_c_re": nrm((L, S5_GROUPS, S5_GROUP_CH, S5_STATE), (2.0 * S5_STATE) ** -0.5),
        "s5_c_im": nrm((L, S5_GROUPS, S5_GROUP_CH, S5_STATE), (2.0 * S5_STATE) ** -0.5),
        "s5_d": nrm((L, S5_WIDTH), 1.0),
        "s5_glu_w": nrm((L, S5_WIDTH, S5_WIDTH), S5_WIDTH ** -0.5),
        "s5_glu_b": nrm((L, S5_WIDTH), 0.02),
        "rg_conv_w": nrm((L, RG_CONV, RG_WIDTH), RG_CONV ** -0.5),
        "rg_conv_b": nrm((L, RG_WIDTH), 0.02),
        "rg_wa": nrm((L, RG_BLOCKS, RG_BLOCK_DIM, RG_BLOCK_DIM), RG_BLOCK_DIM ** -0.5),
        "rg_ba": nrm((L, RG_BLOCKS, RG_BLOCK_DIM), 0.02),
        "rg_wx": nrm((L, RG_BLOCKS, RG_BLOCK_DIM, RG_BLOCK_DIM), RG_BLOCK_DIM ** -0.5),
        "rg_bx": nrm((L, RG_BLOCKS, RG_BLOCK_DIM), 0.02),
        "rg_lambda": jnp.log(a_rg / (1.0 - a_rg)),
        "ln1_g": 1.0 + nrm((L, D_MODEL), 0.02),
        "ln1_b": nrm((L, D_MODEL), 0.02),
        "xa_wq": nrm((L, D_MODEL, D_MODEL), D_MODEL ** -0.5),
        "xa_wk": nrm((L, D_MODEL, D_MODEL), D_MODEL ** -0.5),
        "xa_wv": nrm((L, D_MODEL, D_MODEL), BETA * D_MODEL ** -0.5),
        "xa_wo": nrm((L, D_MODEL, D_MODEL), BETA * D_MODEL ** -0.5),
        "ln2_g": 1.0 + nrm((L, D_MODEL), 0.02),
        "ln2_b": nrm((L, D_MODEL), 0.02),
        "mlp_w1": nrm((L, D_MODEL, D_FF), BETA * D_MODEL ** -0.5),
        "mlp_w2": nrm((L, D_FF, D_MODEL), BETA * D_FF ** -0.5),
        "ln3_g": 1.0 + nrm((L, D_MODEL), 0.02),
        "ln3_b": nrm((L, D_MODEL), 0.02),
    }


def reference(x, mem, w_in, w_out, ssd_conv_w, ssd_conv_b, ssd_dt_bias, ssd_a_log, ssd_d, ssd_norm_w,
              s5_lam_re, s5_lam_im, s5_log_step, s5_b_re, s5_b_im, s5_c_re, s5_c_im, s5_d, s5_glu_w, s5_glu_b,
              rg_conv_w, rg_conv_b, rg_wa, rg_ba, rg_wx, rg_bx, rg_lambda, ln1_g, ln1_b,
              xa_wq, xa_wk, xa_wv, xa_wo, ln2_g, ln2_b, mlp_w1, mlp_w2, ln3_g, ln3_b):
    f32 = jnp.float32
    out_dtype = x.dtype
    h = x.astype(f32)
    memf = mem.astype(f32)
    split_idx = []
    acc = 0
    for w in IN_COLS[:-1]:
        acc += w
        split_idx.append(acc)
    for l in range(DEPTH):
        proj = jnp.einsum('bld,dk->blk', h, w_in[l].astype(f32))
        z, xbc, dt_raw, u_s5, x_rg, g_rg = jnp.split(proj, split_idx, axis=-1)
        y_ssd = ssd_mixer(z, xbc, dt_raw, ssd_conv_w[l], ssd_conv_b[l], ssd_dt_bias[l], ssd_a_log[l],
                          ssd_d[l], ssd_norm_w[l])
        y_s5 = s5_mixer(u_s5, s5_lam_re[l], s5_lam_im[l], s5_log_step[l], s5_b_re[l], s5_b_im[l],
                        s5_c_re[l], s5_c_im[l], s5_d[l], s5_glu_w[l], s5_glu_b[l])
        y_rg = rglru_mixer(x_rg, g_rg, rg_conv_w[l], rg_conv_b[l], rg_wa[l], rg_ba[l], rg_wx[l], rg_bx[l],
                           rg_lambda[l])
        y = jnp.concatenate([y_ssd, y_s5, y_rg], axis=-1)
        y = jnp.einsum('ble,ed->bld', y, w_out[l].astype(f32))
        h = layer_norm(ALPHA * h + y, ln1_g[l], ln1_b[l])
        h = layer_norm(ALPHA * h + cross_attention(h, memf, xa_wq[l], xa_wk[l], xa_wv[l], xa_wo[l]),
                       ln2_g[l], ln2_b[l])
        h = layer_norm(ALPHA * h + squared_relu_mlp(h, mlp_w1[l], mlp_w2[l]), ln3_g[l], ln3_b[l])
    return h.astype(out_dtype)
```

```cpp
#include <hip/hip_runtime.h>
#include <hip/hip_cooperative_groups.h>
#include <cstdio>
#include <cstdint>
namespace cg = cooperative_groups;

#define LAS __attribute__((address_space(3)))
typedef unsigned short bf16_t;
typedef short bf16x8 __attribute__((ext_vector_type(8)));
typedef float f32x4 __attribute__((ext_vector_type(4)));
typedef float f32x2 __attribute__((ext_vector_type(2)));
typedef unsigned u32x4 __attribute__((ext_vector_type(4)));
typedef unsigned u32x2 __attribute__((ext_vector_type(2)));

constexpr int NTOK = 16384, DM = 1024, SEQ = 8192, DFF = 4096, DIN = 2312;
constexpr int PJ = 2304;
constexpr int NWAVES = 8, NTHR = 512;
constexpr float LN_EPS = 1e-5f;
constexpr float ALPHA = 1.41421356237f;
constexpr int LDS_BYTES = 131072 + 2048;

constexpr size_t MiB = 1u << 20;
constexpr size_t WS_DT = 0;
constexpr size_t WS_ACS = 512 * 1024;
constexpr size_t WS_S5E = 1 * MiB;
constexpr size_t WS_RGEA = 2 * MiB;
constexpr size_t WS_RGEH = 2 * MiB + 256 * 1024;
constexpr size_t WS_MEMB = 3 * MiB;
constexpr size_t WS_KB = 4 * MiB;
constexpr size_t WS_VT = 5 * MiB;
constexpr size_t WS_W = 8 * MiB;
constexpr size_t WS_HB = 40 * MiB;
constexpr size_t WS_XDT = 40 * MiB;
constexpr size_t WS_XN = 56 * MiB;
constexpr size_t WS_BIG = 72 * MiB;
constexpr size_t WS_PROJ = 72 * MiB;
constexpr size_t WS_BN = 144 * MiB;
constexpr size_t WS_BT = 152 * MiB;
constexpr size_t WS_CN = 160 * MiB;
constexpr size_t WS_ST = 168 * MiB;
constexpr size_t WS_YS5 = 184 * MiB;
constexpr size_t WS_HLOC = 192 * MiB;
constexpr size_t WS_ACUM = 208 * MiB;
constexpr size_t WS_Y = 224 * MiB;
constexpr size_t WS_Q = 72 * MiB;
constexpr size_t WS_P = 104 * MiB;
constexpr size_t WS_AO = 136 * MiB;
constexpr size_t WS_HID = 72 * MiB;
constexpr size_t WS_END = 256 * MiB;
constexpr size_t WO_IN = 0, WO_OUT = 2621440, WO_Q = WO_OUT + 1048576, WO_K = WO_Q + 1048576, WO_V = WO_K + 1048576, WO_O = WO_V + 1048576,
                 WO_W1 = WO_O + 1048576, WO_W2 = WO_W1 + 4194304, WO_GLU = WO_W2 + 4194304, WO_RG = WO_GLU + 65536;

__device__ __forceinline__ unsigned f2bf(float f) { unsigned u = __builtin_bit_cast(unsigned, f); return (u + 0x7fffu + ((u >> 16) & 1u)) >> 16; }
__device__ __forceinline__ unsigned pk2(float lo, float hi) { return f2bf(lo) | (f2bf(hi) << 16); }
__device__ __forceinline__ float bf2f(unsigned short b) { return __builtin_bit_cast(float, (unsigned)b << 16); }
__device__ __forceinline__ float bflo(unsigned w) { return __builtin_bit_cast(float, w << 16); }
__device__ __forceinline__ float bfhi(unsigned w) { return __builtin_bit_cast(float, w & 0xffff0000u); }
__device__ __forceinline__ float sigmoidf_(float x) { return 1.0f / (1.0f + __expf(-x)); }
__device__ __forceinline__ float softplusf_(float x) { return x > 20.f ? x : log1pf(expf(x)); }
__device__ __forceinline__ float gelu_tanh(float x) { const float z = 0.7978845608028654f * (x + 0.044715f * x * x * x); const float t = __expf(2.f * z); const float th = 1.f - 2.f / (t + 1.f); return 0.5f * x * (1.f + th); }
__device__ __forceinline__ float shx(float v, int m, int lane) { return __builtin_bit_cast(float, __builtin_amdgcn_ds_bpermute((lane ^ m) << 2, __builtin_bit_cast(int, v))); }
__device__ __forceinline__ float shl_(float v, int src, int) { return __builtin_bit_cast(float, __builtin_amdgcn_ds_bpermute(src << 2, __builtin_bit_cast(int, v))); }
__device__ __forceinline__ float wave_sum(float v, int lane) {
#pragma unroll
    for (int o = 1; o < 64; o <<= 1) v += shx(v, o, lane);
    return v;
}
#define WAVE_SYNC() do { asm volatile("s_waitcnt lgkmcnt(0)" ::: "memory"); __builtin_amdgcn_wave_barrier(); } while (0)

struct Params {
    const float* in[39];
    float* out;
    unsigned char* ws;
};
typedef const __attribute__((address_space(4))) Params* KP;
enum { I_X = 0, I_MEM, I_WIN, I_WOUT, I_SCW, I_SCB, I_SDTB, I_SALOG, I_SD, I_SNW, I_LRE, I_LIM, I_LSTEP, I_BRE, I_BIM, I_CRE, I_CIM, I_S5D, I_GLUW, I_GLUB,
       I_RCW, I_RCB, I_RWA, I_RBA, I_RWX, I_RBX, I_RLAM, I_LN1G, I_LN1B, I_WQ, I_WK, I_WV, I_WO, I_LN2G, I_LN2B, I_W1, I_W2, I_LN3G, I_LN3B };

namespace pg8 {
constexpr int BM = 256, BK = 64, HALF = 128, HTB = HALF * BK * 2, STAGE_BYTES = 8 * HTB;
__device__ __forceinline__ int lds_byte(int r, int c) { const int st = (r >> 4) * 2 + (c >> 5), rr = r & 15, cc = c & 31, ob = rr * 64 + cc * 2; return st * 1024 + (ob ^ (((ob >> 9) & 1) << 5)); }
__device__ __forceinline__ void stage_rc(int b, int& R, int& C) { const int st = b / 1024, sb = b % 1024, swz = sb ^ (((sb >> 9) & 1) << 5); R = (st >> 1) * 16 + swz / 64; C = (st & 1) * 32 + (swz % 64) / 2; }

struct Unit { int pm, pn, kind; };

struct Sched {
    int mode, G, c, base, nunits;
    const char* A; const char* B; size_t tA, tB;
    const char* ws;
    __device__ __forceinline__ bool next(int i, Unit& u) const {
        const int L = base + i * G + c; if (L >= nunits) return false;
        if (mode == 0) { u.pm = (L & 7) * 8 + ((L >> 3) & 7); u.pn = L >> 6; u.kind = 0; }
        else if (mode == 1) {
            if (L < 640) { u.pm = (L & 7) * 8 + ((L >> 3) & 7); u.pn = L >> 6; u.kind = 0; }
            else if (L < 648) { const int j = L - 640; u.pm = j >> 2; u.pn = j & 3; u.kind = 1; }
            else { const int j = L - 648; u.pn = j >> 2; u.pm = j & 3; u.kind = 2; }
        } else { u.pm = L & 31; u.pn = L >> 5; u.kind = 0; }
        return true;
    }
    __device__ __forceinline__ const char* pa(const Unit& u) const {
        if (mode == 0) return A + (size_t)u.pm * tA;
        if (mode == 1) return (u.kind == 0 ? A : (u.kind == 1 ? ws + WS_MEMB : ws + WS_W + WO_V * 2)) + (size_t)u.pm * tA;
        if (mode == 2) return A + ((size_t)((u.pn >> 2) * 8192 + u.pm * 256) * 1024 + (u.pn & 3) * 256) * 2;
        return A + ((size_t)(u.pn * 8192 + u.pm * 256) * 256) * 2;
    }
    __device__ __forceinline__ const char* pb(const Unit& u) const {
        if (mode == 0) return B + (size_t)u.pn * tB;
        if (mode == 1) return (u.kind == 0 ? B : (u.kind == 1 ? ws + WS_W + WO_K * 2 : ws + WS_MEMB)) + (size_t)u.pn * tB;
        if (mode == 2) return B + ((size_t)((u.pn >> 2) * 256) * 1024 + (u.pn & 3) * 256) * 2;
        return B + ((size_t)((u.pn >> 2) * 1024 + (u.pn & 3) * 256) * 256) * 2;
    }
};

__device__ __forceinline__ u32x2 pk4(f32x4 v) { u32x2 w; w.x = pk2(v[0], v[1]); w.y = pk2(v[2], v[3]); return w; }

struct Epi {
    static constexpr bool AFTER_DRAIN = false;
    int mode;
    unsigned char* ws; float* o32; const float* gb; size_t o16off; int ldo; float scale; int act;
    __device__ __forceinline__ void operator()(const f32x4 (&acc)[2][2][4][2], const Unit& u, int wr, int wc, int fr, int fq) const {
        const int rl0 = wr * 64 + fr, cl0 = wc * 32 + 4 * fq;
        if (mode == 1) {
            float* base = o32 + (size_t)(u.pm * BM + rl0) * 1024 + u.pn * BM + cl0;
#pragma unroll
            for (int ai = 0; ai < 2; ++ai)
#pragma unroll
                for (int m = 0; m < 4; ++m) { float* rp = base + (size_t)(ai * HALF + m * 16) * 1024;
#pragma unroll
                    for (int bj = 0; bj < 2; ++bj)
#pragma unroll
                        for (int n = 0; n < 2; ++n) { float* p = rp + bj * HALF + n * 16; const f32x4 b = *(const f32x4*)p; *(f32x4*)p = b * ALPHA + acc[ai][bj][m][n]; }
                    asm volatile("" ::: "memory"); }
        } else if (mode == 4) {
            const bf16_t* ysb = (const bf16_t*)(ws + WS_YS5) + (size_t)(u.pm * BM + rl0) * 256 + cl0;
            bf16_t* yb = (bf16_t*)(ws + WS_Y) + (size_t)(u.pm * BM + rl0) * 1024 + 512 + cl0;
#pragma unroll
            for (int bj = 0; bj < 2; ++bj)
#pragma unroll
                for (int n = 0; n < 2; ++n) { const f32x4 g = *(const f32x4*)(gb + cl0 + bj * HALF + n * 16);
#pragma unroll
                    for (int ai = 0; ai < 2; ++ai)
#pragma unroll
                        for (int m = 0; m < 4; ++m) { const int ro = ai * HALF + m * 16; const f32x4 v = acc[ai][bj][m][n];
                            const u32x2 yw = *(const u32x2*)(ysb + (size_t)ro * 256 + bj * HALF + n * 16);
                            f32x4 o;
                            o[0] = bflo(yw.x) * sigmoidf_(v[0] + g[0]); o[1] = bfhi(yw.x) * sigmoidf_(v[1] + g[1]);
                            o[2] = bflo(yw.y) * sigmoidf_(v[2] + g[2]); o[3] = bfhi(yw.y) * sigmoidf_(v[3] + g[3]);
                            *(u32x2*)(yb + (size_t)ro * 1024 + bj * HALF + n * 16) = pk4(o); if (m & 1) asm volatile("" ::: "memory"); } }
        } else if (mode == 0 && u.kind == 0 && u.pn == 9) {
            if (wc == 0 && fq < 2) {
                float* db = (float*)(ws + WS_DT) + (size_t)(u.pm * BM + rl0) * 8 + 4 * fq;
#pragma unroll
                for (int ai = 0; ai < 2; ++ai)
#pragma unroll
                    for (int m = 0; m < 4; ++m) *(f32x4*)(db + (size_t)(ai * HALF + m * 16) * 8) = acc[ai][0][m][0];
            }
        } else {
            bf16_t* ob; int ld; float sc = 1.f; bool sq = false;
            if (mode == 0) {
                if (u.kind == 0) { ob = (bf16_t*)(ws + WS_PROJ) + (size_t)(u.pm * BM) * PJ + u.pn * BM; ld = PJ; }
                else if (u.kind == 1) { ob = (bf16_t*)(ws + WS_KB) + (size_t)(u.pm * BM) * 1024 + u.pn * BM; ld = 1024; }
                else { ob = (bf16_t*)(ws + WS_VT) + (size_t)(u.pn * 1024 + u.pm * BM) * 256; ld = 256; }
            } else if (mode == 2) { ob = (bf16_t*)(ws + o16off) + (size_t)(u.pm * BM) * ldo + u.pn * BM; ld = ldo; sc = scale; sq = act == 1; }
            else { ob = (bf16_t*)(ws + WS_AO) + (size_t)((u.pn >> 2) * 8192 + u.pm * BM) * 1024 + (u.pn & 3) * 256; ld = 1024; }
            ob += (size_t)rl0 * ld + cl0;
#pragma unroll
            for (int ai = 0; ai < 2; ++ai)
#pragma unroll
                for (int m = 0; m < 4; ++m) { bf16_t* rp = ob + (size_t)(ai * HALF + m * 16) * ld;
#pragma unroll
                    for (int bj = 0; bj < 2; ++bj)
#pragma unroll
                        for (int n = 0; n < 2; ++n) { f32x4 v = acc[ai][bj][m][n];
                            if (sq) { v[0] = fmaxf(v[0], 0.f); v[1] = fmaxf(v[1], 0.f); v[2] = fmaxf(v[2], 0.f); v[3] = fmaxf(v[3], 0.f); v = v * v; } else v = v * sc;
                            *(u32x2*)(rp + bj * HALF + n * 16) = pk4(v); } }
        }
    }
    __device__ __forceinline__ void fused(f32x4 (&)[2][2][4][2], const Unit&, int, int, int, int, LAS unsigned char*, int, int) const {}
};

struct EpiSoftmax {
    static constexpr bool AFTER_DRAIN = true;
    bf16_t* P;
    __device__ __forceinline__ void operator()(const f32x4 (&)[2][2][4][2], const Unit&, int, int, int, int) const {}
    __device__ __forceinline__ void fused(f32x4 (&acc)[2][2][4][2], const Unit& u, int wr, int wc, int fr, int fq, LAS unsigned char* lds, int wid, int lane) const {
        LAS f32x2* X = (LAS f32x2*)lds;
        float mw[2][4];
#pragma unroll
        for (int ai = 0; ai < 2; ++ai)
#pragma unroll
            for (int m = 0; m < 4; ++m) {
                float mx = -3.0e38f;
#pragma unroll
                for (int bj = 0; bj < 2; ++bj)
#pragma unroll
                    for (int n = 0; n < 2; ++n) { const f32x4 x = acc[ai][bj][m][n]; mx = fmaxf(mx, fmaxf(fmaxf(x[0], x[1]), fmaxf(x[2], x[3]))); }
                mx = fmaxf(mx, shx(mx, 16, lane)); mx = fmaxf(mx, shx(mx, 32, lane));
                float s = 0.f;
#pragma unroll
                for (int bj = 0; bj < 2; ++bj)
#pragma unroll
                    for (int n = 0; n < 2; ++n) { f32x4 x = acc[ai][bj][m][n];
                        x[0] = __expf(x[0] - mx); x[1] = __expf(x[1] - mx); x[2] = __expf(x[2] - mx); x[3] = __expf(x[3] - mx);
                        s += (x[0] + x[1]) + (x[2] + x[3]); acc[ai][bj][m][n] = x; }
                s += shx(s, 16, lane); s += shx(s, 32, lane);
                mw[ai][m] = mx;
                if (fq == 0) X[(ai * HALF + wr * 64 + m * 16 + fr) * 4 + wc] = (f32x2){mx, s};
            }
        asm volatile("s_waitcnt lgkmcnt(0)" ::: "memory"); __builtin_amdgcn_s_barrier(); asm volatile("" ::: "memory");
#pragma unroll
        for (int ai = 0; ai < 2; ++ai)
#pragma unroll
            for (int m = 0; m < 4; ++m) {
                const int rl = ai * HALF + wr * 64 + m * 16 + fr;
                const f32x2 a = X[rl * 4 + 0], b = X[rl * 4 + 1], c = X[rl * 4 + 2], d = X[rl * 4 + 3];
                const float M = fmaxf(fmaxf(a.x, b.x), fmaxf(c.x, d.x));
                const float S = a.y * __expf(a.x - M) + b.y * __expf(b.x - M) + c.y * __expf(c.x - M) + d.y * __expf(d.x - M);
                const float f = __expf(mw[ai][m] - M) / S;
#pragma unroll
                for (int bj = 0; bj < 2; ++bj)
#pragma unroll
                    for (int n = 0; n < 2; ++n) {
                        const int cl = bj * HALF + wc * 32 + n * 16 + 4 * fq;
                        *(u32x2*)(P + ((size_t)u.pn * 8192 + u.pm * BM + rl) * 256 + cl) = pk4(acc[ai][bj][m][n] * f);
                    }
            }
        asm volatile("s_waitcnt lgkmcnt(0)" ::: "memory"); __builtin_amdgcn_s_barrier(); asm volatile("" ::: "memory");
    }
};

template <class EpiT, bool ALIGN_EPI, bool SP2>
__device__ __forceinline__ void gemm_phase(LAS unsigned char* lds, const int lda, const int ldb, const int K, const Sched& S, const EpiT& E, const int tid) {
    const int wid = __builtin_amdgcn_readfirstlane(tid >> 6), lane = tid & 63, wr = wid >> 2, wc = wid & 3, fr = lane & 15, fq = lane >> 4;
    const int nt = K / BK;
    unsigned voffA[2], voffB[2];
#pragma unroll
    for (int i = 0; i < 2; ++i) { int R, C; stage_rc(tid * 16 + i * 8192, R, C); voffA[i] = (unsigned)(R * lda + C) * 2u; voffB[i] = (unsigned)(R * ldb + C) * 2u; }
    const size_t kstep = (size_t)(BK * 2);
    const size_t hstepA = (size_t)HALF * lda * 2, hstepB = (size_t)HALF * ldb * 2;
    const unsigned ldsw = (unsigned)wid * 1024u;
    const int aoff = lds_byte(wr * 64 + fr, fq * 8), boff = lds_byte(wc * 32 + fr, fq * 8);
#define PG8_SA(b, h) (((b) * 2 + (h)) * HTB)
#define PG8_SB(b, h) ((4 + (b) * 2 + (h)) * HTB)
#define PG8_STAGE(bufoff, gbase, voff) do { _Pragma("unroll") for (int _i = 0; _i < 2; ++_i) \
        __builtin_amdgcn_global_load_lds((const unsigned*)((const char*)(gbase) + (voff)[_i]), (LAS unsigned*)(lds + (bufoff) + ldsw + _i * 8192), 16, 0, 0); } while (0)
#define PG8_LDA(dst, b, h) do { _Pragma("unroll") for (int m = 0; m < 4; ++m) _Pragma("unroll") for (int k = 0; k < 2; ++k) dst[m][k] = *(const LAS bf16x8*)(lds + PG8_SA(b, h) + aoff + m * 2048 + k * 1024); } while (0)
#define PG8_LDB(dst, b, h) do { _Pragma("unroll") for (int n = 0; n < 2; ++n) _Pragma("unroll") for (int k = 0; k < 2; ++k) dst[n][k] = *(const LAS bf16x8*)(lds + PG8_SB(b, h) + boff + n * 2048 + k * 1024); } while (0)
#define PG8_MMA(ai, bj, At, Bt) do { __builtin_amdgcn_s_setprio(1); _Pragma("unroll") for (int m = 0; m < 4; ++m) _Pragma("unroll") for (int n = 0; n < 2; ++n) _Pragma("unroll") for (int k = 0; k < 2; ++k) \
        acc[ai][bj][m][n] = __builtin_amdgcn_mfma_f32_16x16x32_bf16(Bt[n][k], At[m][k], acc[ai][bj][m][n], 0, 0, 0); __builtin_amdgcn_s_setprio(0); } while (0)
#define PG8_WAIT_V(n) asm volatile("s_waitcnt vmcnt(" #n ")" ::: "memory")
#define PG8_WAIT_L(n) asm volatile("s_waitcnt lgkmcnt(" #n ")" ::: "memory")
#define PG8_BAR __builtin_amdgcn_s_barrier()
#define PG8_SCHED __builtin_amdgcn_sched_barrier(0)
    Unit cur, nxt; int ui = 0;
    if (!S.next(0, cur)) return;
    f32x4 acc[2][2][4][2];
#pragma unroll
    for (int a = 0; a < 2; ++a)
#pragma unroll
        for (int b = 0; b < 2; ++b)
#pragma unroll
            for (int m = 0; m < 4; ++m)
#pragma unroll
                for (int n = 0; n < 2; ++n) acc[a][b][m][n] = (f32x4){0.f, 0.f, 0.f, 0.f};
    bf16x8 At[4][2], B0[2][2], B1[2][2];
    const char* cA = S.pa(cur); const char* cB = S.pb(cur);
    if constexpr (SP2) {
        PG8_STAGE(PG8_SB(0, 0), cB, voffB); PG8_STAGE(PG8_SB(0, 1), cB + hstepB, voffB); PG8_STAGE(PG8_SA(0, 0), cA, voffA); PG8_STAGE(PG8_SA(0, 1), cA + hstepA, voffA);
        if (wr == 1) PG8_BAR;
        PG8_WAIT_V(2); PG8_BAR;
        PG8_STAGE(PG8_SB(1, 0), cB + kstep, voffB); PG8_STAGE(PG8_SA(1, 0), cA + kstep, voffA); PG8_STAGE(PG8_SB(1, 1), cB + hstepB + kstep, voffB);
        PG8_WAIT_V(6); PG8_BAR;
    } else {
        PG8_STAGE(PG8_SB(0, 0), cB, voffB); PG8_STAGE(PG8_SA(0, 0), cA, voffA); PG8_STAGE(PG8_SB(0, 1), cB + hstepB, voffB); PG8_STAGE(PG8_SA(0, 1), cA + hstepA, voffA);
        if (wr == 1) PG8_BAR;
        PG8_WAIT_V(4); PG8_BAR;
        PG8_STAGE(PG8_SB(1, 0), cB + kstep, voffB); PG8_STAGE(PG8_SA(1, 0), cA + kstep, voffA); PG8_STAGE(PG8_SB(1, 1), cB + hstepB + kstep, voffB);
        PG8_WAIT_V(6); PG8_BAR;
    }
    for (;;) {
        const bool has_next = S.next(ui + 1, nxt);
        const char* nA = has_next ? S.pa(nxt) : cA; const char* nB = has_next ? S.pb(nxt) : cB;
        for (int t = 0; t < nt; t += 2) {
            const bool last = (t == nt - 2);
            const char* a1 = cA + (size_t)(t + 1) * kstep;
            const char* a2 = last ? nA : cA + (size_t)(t + 2) * kstep; const char* b2 = last ? nB : cB + (size_t)(t + 2) * kstep;
            const char* a3 = a2 + kstep; const char* b3 = b2 + kstep;
            if constexpr (SP2) {
            PG8_LDB(B0, 0, 0); PG8_LDB(B1, 0, 1); PG8_SCHED; PG8_LDA(At, 0, 0); PG8_STAGE(PG8_SA(1, 1), a1 + hstepA, voffA);
            PG8_WAIT_V(8); PG8_WAIT_L(0); PG8_BAR; PG8_MMA(0, 0, At, B0); PG8_MMA(0, 1, At, B1); PG8_BAR; PG8_SCHED;
            PG8_LDA(At, 0, 1); PG8_STAGE(PG8_SB(0, 0), b2, voffB); PG8_STAGE(PG8_SB(0, 1), b2 + hstepB, voffB); PG8_STAGE(PG8_SA(0, 0), a2, voffA);
            PG8_WAIT_V(8); PG8_WAIT_L(0); PG8_BAR; PG8_MMA(1, 0, At, B0); PG8_MMA(1, 1, At, B1); PG8_BAR; PG8_SCHED;
            PG8_LDB(B0, 1, 0); PG8_LDB(B1, 1, 1); PG8_SCHED; PG8_LDA(At, 1, 0); PG8_STAGE(PG8_SA(0, 1), a2 + hstepA, voffA);
            PG8_WAIT_V(8); PG8_WAIT_L(0); PG8_BAR; PG8_MMA(0, 0, At, B0); PG8_MMA(0, 1, At, B1); PG8_BAR; PG8_SCHED;
            PG8_LDA(At, 1, 1); PG8_STAGE(PG8_SB(1, 0), b3, voffB); PG8_STAGE(PG8_SB(1, 1), b3 + hstepB, voffB); PG8_STAGE(PG8_SA(1, 0), a3, voffA);
            PG8_WAIT_V(8); PG8_WAIT_L(0); PG8_BAR; PG8_MMA(1, 0, At, B0); PG8_MMA(1, 1, At, B1); PG8_BAR; PG8_SCHED;
            } else {
            PG8_LDB(B0, 0, 0); PG8_SCHED; PG8_LDA(At, 0, 0); PG8_STAGE(PG8_SA(1, 1), a1 + hstepA, voffA);
            PG8_WAIT_L(8); PG8_BAR; PG8_WAIT_L(0); PG8_MMA(0, 0, At, B0); PG8_BAR; PG8_SCHED;
            PG8_LDB(B1, 0, 1); PG8_STAGE(PG8_SB(0, 0), b2, voffB);
            PG8_BAR; PG8_WAIT_L(0); PG8_MMA(0, 1, At, B1); PG8_BAR;
            PG8_LDA(At, 0, 1); PG8_STAGE(PG8_SA(0, 0), a2, voffA);
            PG8_BAR; PG8_WAIT_L(0); PG8_MMA(1, 0, At, B0); PG8_BAR; PG8_SCHED;
            PG8_STAGE(PG8_SB(0, 1), b2 + hstepB, voffB);
            PG8_WAIT_V(6); PG8_BAR; PG8_MMA(1, 1, At, B1); PG8_BAR;
            PG8_LDB(B0, 1, 0); PG8_SCHED; PG8_LDA(At, 1, 0); PG8_STAGE(PG8_SA(0, 1), a2 + hstepA, voffA);
            PG8_WAIT_L(8); PG8_BAR; PG8_WAIT_L(0); PG8_MMA(0, 0, At, B0); PG8_BAR; PG8_SCHED;
            PG8_LDB(B1, 1, 1); PG8_STAGE(PG8_SB(1, 0), b3, voffB);
            PG8_BAR; PG8_WAIT_L(0); PG8_MMA(0, 1, At, B1); PG8_BAR;
            PG8_LDA(At, 1, 1); PG8_STAGE(PG8_SA(1, 0), a3, voffA);
            PG8_BAR; PG8_WAIT_L(0); PG8_MMA(1, 0, At, B0); PG8_BAR; PG8_SCHED;
            PG8_STAGE(PG8_SB(1, 1), b3 + hstepB, voffB);
            PG8_WAIT_V(6); PG8_BAR; PG8_MMA(1, 1, At, B1); PG8_BAR;
            }
        }
        if constexpr (ALIGN_EPI) { if (wr == 0) PG8_BAR; }
        if constexpr (!EpiT::AFTER_DRAIN) { E(acc, cur, wr, wc, fr, fq); }
        if (!has_next) break;
#pragma unroll
        for (int a = 0; a < 2; ++a)
#pragma unroll
            for (int b = 0; b < 2; ++b)
#pragma unroll
                for (int m = 0; m < 4; ++m)
#pragma unroll
                    for (int n = 0; n < 2; ++n) acc[a][b][m][n] = (f32x4){0.f, 0.f, 0.f, 0.f};
        cur = nxt; cA = nA; cB = nB; ++ui;
        if constexpr (ALIGN_EPI) { if (wr == 1) PG8_BAR; }
    }
    PG8_WAIT_V(0);
    if constexpr (!ALIGN_EPI) { if (wr == 0) PG8_BAR; }
    PG8_BAR;
    if constexpr (EpiT::AFTER_DRAIN) { E.fused(acc, cur, wr, wc, fr, fq, lds, wid, lane); }
#undef PG8_SA
#undef PG8_SB
#undef PG8_STAGE
#undef PG8_LDA
#undef PG8_LDB
#undef PG8_MMA
#undef PG8_WAIT_V
#undef PG8_WAIT_L
#undef PG8_BAR
#undef PG8_SCHED
}
}

__device__ __forceinline__ void transpose_item(const float* W, int K, int N, bf16_t* WT, LAS float* scr, int kb, int nb, int lane, bool inmap) {
    const int k0 = 64 * kb, n0 = 32 * nb;
    const int dr = n0 + (lane & 31);
    int sc = dr;
    if (inmap) sc = dr < 1536 ? dr : (dr < 2304 ? dr + 8 : (dr < 2312 ? dr - 2304 + 1536 : -1));
#pragma unroll 8
    for (int i = 0; i < 32; ++i) { const int kk = 2 * i + (lane >> 5); scr[kk * 33 + (lane & 31)] = sc >= 0 ? W[(size_t)(k0 + kk) * N + sc] : 0.f; }
    WAVE_SYNC();
    const int c = lane & 7;
#pragma unroll
    for (int j = 0; j < 4; ++j) { const int n = (lane >> 3) + 8 * j; const LAS float* s = scr + (8 * c) * 33 + n;
        u32x4 o; o.x = pk2(s[0 * 33], s[1 * 33]); o.y = pk2(s[2 * 33], s[3 * 33]); o.z = pk2(s[4 * 33], s[5 * 33]); o.w = pk2(s[6 * 33], s[7 * 33]);
        *(u32x4*)(WT + (size_t)(n0 + n) * K + k0 + 8 * c) = o; }
    WAVE_SYNC();
}

__device__ __forceinline__ void convert_weights(KP P, int layer, LAS unsigned char* lds, int gw, int NGW, int wave, int lane) {
    LAS float* scr = (LAS float*)(lds + wave * 8704);
    bf16_t* W = (bf16_t*)(P->ws + WS_W);
    constexpr int I_IN = 16 * 80, I_SQ = 16 * 32, I_1 = 16 * 128, I_2 = 64 * 32, I_G = 4 * 8;
    constexpr int NIT = I_IN + 5 * I_SQ + I_1 + I_2 + I_G;
    for (int it = gw; it < NIT; it += NGW) {
        int r = it;
        if (r < I_IN) { transpose_item(P->in[I_WIN] + (size_t)layer * 1024 * DIN, 1024, DIN, W + WO_IN, scr, r / 80, r % 80, lane, true); continue; } r -= I_IN;
        if (r < I_SQ) { transpose_item(P->in[I_WOUT] + (size_t)layer * 1048576, 1024, 1024, W + WO_OUT, scr, r / 32, r % 32, lane, false); continue; } r -= I_SQ;
        if (r < I_SQ) { transpose_item(P->in[I_WQ] + (size_t)layer * 1048576, 1024, 1024, W + WO_Q, scr, r / 32, r % 32, lane, false); continue; } r -= I_SQ;
        if (r < I_SQ) { transpose_item(P->in[I_WK] + (size_t)layer * 1048576, 1024, 1024, W + WO_K, scr, r / 32, r % 32, lane, false); continue; } r -= I_SQ;
        if (r < I_SQ) { transpose_item(P->in[I_WV] + (size_t)layer * 1048576, 1024, 1024, W + WO_V, scr, r / 32, r % 32, lane, false); continue; } r -= I_SQ;
        if (r < I_SQ) { transpose_item(P->in[I_WO] + (size_t)layer * 1048576, 1024, 1024, W + WO_O, scr, r / 32, r % 32, lane, false); continue; } r -= I_SQ;
        if (r < I_1) { transpose_item(P->in[I_W1] + (size_t)layer * 4194304, 1024, 4096, W + WO_W1, scr, r / 128, r % 128, lane, false); continue; } r -= I_1;
        if (r < I_2) { transpose_item(P->in[I_W2] + (size_t)layer * 4194304, 4096, 1024, W + WO_W2, scr, r / 32, r % 32, lane, false); continue; } r -= I_2;
        transpose_item(P->in[I_GLUW] + (size_t)layer * 65536, 256, 256, W + WO_GLU, scr, r / 8, r % 8, lane, false);
    }
    const float* wa = P->in[I_RWA] + (size_t)layer * 16384; const float* wx = P->in[I_RWX] + (size_t)layer * 16384;
    for (int e = gw * 64 + lane; e < 32768; e += NGW * 64) {
        const int blk = e >> 13, o = (e >> 6) & 127, i = e & 63;
        const float v = o < 64 ? wa[(blk * 64 + i) * 64 + o] : wx[(blk * 64 + i) * 64 + (o - 64)];
        W[WO_RG + e] = (bf16_t)f2bf(v);
    }
}

__device__ __forceinline__ void ln_rows(KP P, const float* g, const float* b, int gw, int NGW, int lane) {
    bf16_t* hb = (bf16_t*)(P->ws + WS_HB);
    f32x4 gv[4], bv[4];
#pragma unroll
    for (int j = 0; j < 4; ++j) { gv[j] = *(const f32x4*)(g + 4 * lane + 256 * j); bv[j] = *(const f32x4*)(b + 4 * lane + 256 * j); }
    for (int r = gw; r < NTOK; r += NGW) {
        f32x4* xr = (f32x4*)(P->out + (size_t)r * DM) + lane;
        f32x4 v[4]; float s = 0.f;
#pragma unroll
        for (int j = 0; j < 4; ++j) { v[j] = xr[64 * j]; s += (v[j].x + v[j].y) + (v[j].z + v[j].w); }
        const float mean = wave_sum(s, lane) * (1.f / DM); float s2 = 0.f;
#pragma unroll
        for (int j = 0; j < 4; ++j) { v[j] = v[j] - mean; s2 += (v[j].x * v[j].x + v[j].y * v[j].y) + (v[j].z * v[j].z + v[j].w * v[j].w); }
        const float rstd = 1.f / sqrtf(wave_sum(s2, lane) * (1.f / DM) + LN_EPS);
        u32x2* o8 = (u32x2*)(hb + (size_t)r * DM) + lane;
#pragma unroll
        for (int j = 0; j < 4; ++j) { const f32x4 o = v[j] * rstd * gv[j] + bv[j]; xr[64 * j] = o; u32x2 w; w.x = pk2(o.x, o.y); w.y = pk2(o.z, o.w); o8[64 * j] = w; }
    }
}

__device__ __forceinline__ void ssd_prep_unit(KP P, int layer, int c, int q, LAS unsigned char* lds, const int tid) {
    const int lane = tid & 63, wave = tid >> 6;
    const int tok0 = c * 128;
    LAS float* dts = (LAS float*)lds;
    const bf16_t* proj = (const bf16_t*)(P->ws + WS_PROJ);
    __syncthreads();
    if (q < 2) {
        const int h = wave;
        const float* dtb = (const float*)(P->ws + WS_DT);
        const float bias = P->in[I_SDTB][layer * 8 + h], a = -expf(P->in[I_SALOG][layer * 8 + h]);
        const float d0 = softplusf_(dtb[(size_t)(tok0 + lane) * 8 + h] + bias), d1 = softplusf_(dtb[(size_t)(tok0 + lane + 64) * 8 + h] + bias);
        dts[h * 128 + lane] = d0; dts[h * 128 + lane + 64] = d1;
        if (q == 0) {
            float s0 = d0 * a, s1 = d1 * a;
#pragma unroll
            for (int d = 1; d < 64; d <<= 1) { const float t0 = shl_(s0, (lane - d) & 63, lane), t1 = shl_(s1, (lane - d) & 63, lane); if (lane >= d) { s0 += t0; s1 += t1; } }
            const float tot0 = shl_(s0, 63 + (lane & 0), lane);
            float* acs = (float*)(P->ws + WS_ACS) + (size_t)(c * 8 + h) * 128;
            acs[lane] = s0; acs[lane + 64] = s1 + tot0;
        }
    }
    __syncthreads();
    const int chl = tid & 255, half = tid >> 8;
    const int xch = q * 256 + chl;
    const float* cw = P->in[I_SCW] + (size_t)layer * 4096; const float cb = P->in[I_SCB][layer * 1024 + xch];
    const float w0 = cw[xch], w1 = cw[1024 + xch], w2 = cw[2048 + xch], w3 = cw[3072 + xch];
    const bf16_t* src = proj + (size_t)tok0 * PJ + 512 + xch;
    const int l0 = half * 64;
    const bool seq_start = ((c & 63) == 0) && (half == 0);
    float xm3 = 0.f, xm2 = 0.f, xm1 = 0.f;
    if (!seq_start) { xm3 = bf2f(src[(ptrdiff_t)(l0 - 3) * PJ]); xm2 = bf2f(src[(ptrdiff_t)(l0 - 2) * PJ]); xm1 = bf2f(src[(ptrdiff_t)(l0 - 1) * PJ]); }
    bf16_t* Xn = (bf16_t*)(P->ws + WS_XN); bf16_t* Xdt = (bf16_t*)(P->ws + WS_XDT);
    bf16_t* Bn = (bf16_t*)(P->ws + WS_BN); bf16_t* Bt = (bf16_t*)(P->ws + WS_BT); bf16_t* Cn = (bf16_t*)(P->ws + WS_CN);
    const int hh = q * 4 + (chl >> 6), pp = chl & 63;
    for (int l8 = 0; l8 < 8; ++l8) {
        const int lb = l0 + l8 * 8;
        float xv[8], ov[8];
#pragma unroll
        for (int i = 0; i < 8; ++i) xv[i] = bf2f(src[(size_t)(lb + i) * PJ]);
#pragma unroll
        for (int i = 0; i < 8; ++i) {
            const float a3 = i >= 3 ? xv[i - 3] : (i == 0 ? xm3 : (i == 1 ? xm2 : xm1));
            const float a2 = i >= 2 ? xv[i - 2] : (i == 0 ? xm2 : xm1);
            const float a1 = i >= 1 ? xv[i - 1] : xm1;
            const float y = cb + w0 * a3 + w1 * a2 + w2 * a1 + w3 * xv[i];
            ov[i] = y * sigmoidf_(y);
        }
        xm3 = xv[5]; xm2 = xv[6]; xm1 = xv[7];
        if (q < 2) {
#pragma unroll
            for (int i = 0; i < 8; ++i) Xn[(size_t)(tok0 + lb + i) * 512 + xch] = (bf16_t)f2bf(ov[i]);
            float dv[8];
#pragma unroll
            for (int i = 0; i < 8; ++i) dv[i] = ov[i] * dts[hh * 128 + lb + i];
            u32x4 o; o.x = pk2(dv[0], dv[1]); o.y = pk2(dv[2], dv[3]); o.z = pk2(dv[4], dv[5]); o.w = pk2(dv[6], dv[7]);
            *(u32x4*)(Xdt + ((size_t)(c * 8 + hh) * 64 + pp) * 128 + lb) = o;
        } else if (q == 2) {
#pragma unroll
            for (int i = 0; i < 8; ++i) Bn[(size_t)(tok0 + lb + i) * 256 + chl] = (bf16_t)f2bf(ov[i]);
            u32x4 o; o.x = pk2(ov[0], ov[1]); o.y = pk2(ov[2], ov[3]); o.z = pk2(ov[4], ov[5]); o.w = pk2(ov[6], ov[7]);
            *(u32x4*)(Bt + ((size_t)(c * 2 + (chl >> 7)) * 128 + (chl & 127)) * 128 + lb) = o;
        } else {
#pragma unroll
            for (int i = 0; i < 8; ++i) Cn[(size_t)(tok0 + lb + i) * 256 + chl] = (bf16_t)f2bf(ov[i]);
        }
    }
}

__device__ __forceinline__ void ssd_states_item(KP P, int idx, LAS unsigned char* wlds, int lane) {
    const int c = idx >> 4, h = (idx >> 1) & 7, nh = idx & 1, g = h >> 2, fr = lane & 15, fq = lane >> 4;
    LAS float* dec = (LAS float*)wlds;
    const float* acs = (const float*)(P->ws + WS_ACS) + (size_t)(c * 8 + h) * 128;
    const float aend = acs[127];
    WAVE_SYNC();
    dec[lane] = __expf(aend - acs[lane]); dec[lane + 64] = __expf(aend - acs[lane + 64]);
    WAVE_SYNC();
    const bf16_t* Xdt = (const bf16_t*)(P->ws + WS_XDT) + (size_t)(c * 8 + h) * 64 * 128;
    const bf16_t* Bt = (const bf16_t*)(P->ws + WS_BT) + ((size_t)(c * 2 + g) * 128 + nh * 64) * 128;
    f32x4 acc[4][4];
#pragma unroll
    for (int a = 0; a < 4; ++a)
#pragma unroll
        for (int b = 0; b < 4; ++b) acc[a][b] = (f32x4){0.f, 0.f, 0.f, 0.f};
#pragma unroll
    for (int ks = 0; ks < 4; ++ks) {
        const f32x4 d0 = *(const LAS f32x4*)(dec + ks * 32 + fq * 8), d1 = *(const LAS f32x4*)(dec + ks * 32 + fq * 8 + 4);
        bf16x8 af[4], bfr[4];
#pragma unroll
        for (int pt = 0; pt < 4; ++pt) {
            const u32x4 raw = *(const u32x4*)(Xdt + (size_t)(pt * 16 + fr) * 128 + ks * 32 + fq * 8);
            u32x4 o;
            o.x = pk2(bflo(raw.x) * d0[0], bfhi(raw.x) * d0[1]); o.y = pk2(bflo(raw.y) * d0[2], bfhi(raw.y) * d0[3]);
            o.z = pk2(bflo(raw.z) * d1[0], bfhi(raw.z) * d1[1]); o.w = pk2(bflo(raw.w) * d1[2], bfhi(raw.w) * d1[3]);
            af[pt] = __builtin_bit_cast(bf16x8, o);
        }
#pragma unroll
        for (int nt = 0; nt < 4; ++nt) bfr[nt] = *(const bf16x8*)(Bt + (size_t)(nt * 16 + fr) * 128 + ks * 32 + fq * 8);
#pragma unroll
        for (int pt = 0; pt < 4; ++pt)
#pragma unroll
            for (int nt = 0; nt < 4; ++nt) acc[pt][nt] = __builtin_amdgcn_mfma_f32_16x16x32_bf16(af[pt], bfr[nt], acc[pt][nt], 0, 0, 0);
    }
    bf16_t* st = (bf16_t*)(P->ws + WS_ST) + (size_t)(c * 8 + h) * 64 * 128 + nh * 64;
#pragma unroll
    for (int pt = 0; pt < 4; ++pt)
#pragma unroll
        for (int nt = 0; nt < 4; ++nt)
#pragma unroll
            for (int jj = 0; jj < 4; ++jj) st[(size_t)(pt * 16 + fq * 4 + jj) * 128 + nt * 16 + fr] = (bf16_t)f2bf(acc[pt][nt][jj]);
}

__device__ __forceinline__ void ssd_scan_item(KP P, int idx, int lane) {
    const int tix = idx * 64 + lane;
    const int b = tix >> 13, rem = tix & 8191, h = rem >> 10, p = (rem >> 4) & 63, n8 = rem & 15;
    float run[8];
#pragma unroll
    for (int i = 0; i < 8; ++i) run[i] = 0.f;
    const float* acs = (const float*)(P->ws + WS_ACS);
    bf16_t* st = (bf16_t*)(P->ws + WS_ST);
#pragma unroll 4
    for (int cc = 0; cc < 64; ++cc) {
        const int c = b * 64 + cc;
        u32x4* ptr = (u32x4*)(st + ((size_t)(c * 8 + h) * 64 + p) * 128 + n8 * 8);
        const u32x4 s = *ptr;
        const float dec = __expf(acs[(size_t)(c * 8 + h) * 128 + 127]);
        u32x4 o; o.x = pk2(run[0], run[1]); o.y = pk2(run[2], run[3]); o.z = pk2(run[4], run[5]); o.w = pk2(run[6], run[7]);
        *ptr = o;
        run[0] = run[0] * dec + bflo(s.x); run[1] = run[1] * dec + bfhi(s.x); run[2] = run[2] * dec + bflo(s.y); run[3] = run[3] * dec + bfhi(s.y);
        run[4] = run[4] * dec + bflo(s.z); run[5] = run[5] * dec + bfhi(s.z); run[6] = run[6] * dec + bflo(s.w); run[7] = run[7] * dec + bfhi(s.w);
    }
}

__device__ __forceinline__ void ssd_final_item(KP P, int layer, int idx, LAS unsigned char* wlds, int lane) {
    const int c = idx >> 3, lt = idx & 7, fr = lane & 15, fq = lane >> 4;
    const int tok0 = c * 128;
    LAS bf16_t* Ms = (LAS bf16_t*)wlds;
    const bf16_t* proj = (const bf16_t*)(P->ws + WS_PROJ);
    const bf16_t* Xn = (const bf16_t*)(P->ws + WS_XN);
    const bf16_t* Cn = (const bf16_t*)(P->ws + WS_CN);
    const bf16_t* Bn = (const bf16_t*)(P->ws + WS_BN);
    bf16_t* Y = (bf16_t*)(P->ws + WS_Y);
    float ssq[4] = {0.f, 0.f, 0.f, 0.f};
#pragma nounroll
    for (int g = 0; g < 2; ++g) {
        bf16x8 cf[4];
#pragma unroll
        for (int ks = 0; ks < 4; ++ks) cf[ks] = *(const bf16x8*)(Cn + (size_t)(tok0 + lt * 16 + fr) * 256 + g * 128 + ks * 32 + fq * 8);
        f32x4 cb[8];
#pragma unroll
        for (int st = 0; st < 8; ++st) {
            cb[st] = (f32x4){0.f, 0.f, 0.f, 0.f};
#pragma unroll
            for (int ks = 0; ks < 4; ++ks) {
                const bf16x8 bb = *(const bf16x8*)(Bn + (size_t)(tok0 + st * 16 + fr) * 256 + g * 128 + ks * 32 + fq * 8);
                cb[st] = __builtin_amdgcn_mfma_f32_16x16x32_bf16(cf[ks], bb, cb[st], 0, 0, 0);
            }
            if (st & 1) asm volatile("" ::: "memory");
        }
#pragma nounroll
        for (int hh = 0; hh < 4; ++hh) {
            const int h = g * 4 + hh;
            const float* ac = (const float*)(P->ws + WS_ACS) + (size_t)(c * 8 + h) * 128;
            float al[4];
#pragma unroll
            for (int jj = 0; jj < 4; ++jj) al[jj] = ac[lt * 16 + fq * 4 + jj];
            WAVE_SYNC();
#pragma unroll
            for (int st = 0; st < 8; ++st) {
                const float as_ = ac[st * 16 + fr];
                const int s = st * 16 + fr;
#pragma unroll
                for (int jj = 0; jj < 4; ++jj) {
                    const int l = lt * 16 + fq * 4 + jj;
                    const float v = (s <= l) ? cb[st][jj] * __expf(al[jj] - as_) : 0.f;
                    Ms[(fq * 4 + jj) * 136 + s] = (bf16_t)f2bf(v);
                }
            }
            WAVE_SYNC();
            bf16x8 mf[4];
#pragma unroll
            for (int ks = 0; ks < 4; ++ks) mf[ks] = *(const LAS bf16x8*)(Ms + fr * 136 + ks * 32 + fq * 8);
            const bf16_t* Xdt = (const bf16_t*)(P->ws + WS_XDT) + (size_t)(c * 8 + h) * 64 * 128;
            const bf16_t* prev = (const bf16_t*)(P->ws + WS_ST) + (size_t)(c * 8 + h) * 64 * 128;
            const float Dh = P->in[I_SD][layer * 8 + h];
#pragma nounroll
            for (int pt = 0; pt < 4; ++pt) {
                f32x4 ad = (f32x4){0.f, 0.f, 0.f, 0.f}, ao = (f32x4){0.f, 0.f, 0.f, 0.f};
#pragma unroll
                for (int ks = 0; ks < 4; ++ks) {
                    const bf16x8 bx = *(const bf16x8*)(Xdt + (size_t)(pt * 16 + fr) * 128 + ks * 32 + fq * 8);
                    ad = __builtin_amdgcn_mfma_f32_16x16x32_bf16(mf[ks], bx, ad, 0, 0, 0);
                }
#pragma unroll
                for (int ks = 0; ks < 4; ++ks) {
                    const bf16x8 bp = *(const bf16x8*)(prev + (size_t)(pt * 16 + fr) * 128 + ks * 32 + fq * 8);
                    ao = __builtin_amdgcn_mfma_f32_16x16x32_bf16(cf[ks], bp, ao, 0, 0, 0);
                }
                const int ch = h * 64 + pt * 16 + fr;
#pragma unroll
                for (int jj = 0; jj < 4; ++jj) {
                    const size_t tok = (size_t)(tok0 + lt * 16 + fq * 4 + jj);
                    const float xv = bf2f(Xn[tok * 512 + ch]);
                    const float zv = bf2f(proj[tok * PJ + ch]);
                    float y = ad[jj] + __expf(al[jj]) * ao[jj] + Dh * xv;
                    y *= zv * sigmoidf_(zv);
                    const unsigned yb = f2bf(y); const float yr = bf2f((unsigned short)yb);
                    Y[tok * 1024 + ch] = (bf16_t)yb; ssq[jj] += yr * yr;
                }
            }
        }
    }
    float rstd[4];
#pragma unroll
    for (int jj = 0; jj < 4; ++jj) { float s = ssq[jj]; s += shx(s, 1, lane); s += shx(s, 2, lane); s += shx(s, 4, lane); s += shx(s, 8, lane); rstd[jj] = 1.f / sqrtf(s * (1.f / 512.f) + LN_EPS); }
    const float* nw = P->in[I_SNW] + layer * 512;
    asm volatile("s_waitcnt vmcnt(0)" ::: "memory");
#pragma nounroll
    for (int h = 0; h < 8; ++h)
#pragma unroll
        for (int pt = 0; pt < 4; ++pt) {
            const int ch = h * 64 + pt * 16 + fr; const float w = nw[ch];
#pragma unroll
            for (int jj = 0; jj < 4; ++jj) { bf16_t* yp = Y + (size_t)(tok0 + lt * 16 + fq * 4 + jj) * 1024 + ch; *yp = (bf16_t)f2bf(bf2f(*yp) * rstd[jj] * w); }
        }
}

struct S5C { float lbr, lbi; f32x2 bt[16]; };
__device__ __forceinline__ void s5_consts(KP P, int layer, int g, int p, S5C& K) {
    const float lre = P->in[I_LRE][(layer * 16 + g) * 64 + p], lim = P->in[I_LIM][(layer * 16 + g) * 64 + p];
    const float step = expf(P->in[I_LSTEP][layer * 16 + g]);
    const float mag = expf(lre * step), ang = lim * step;
    K.lbr = mag * cosf(ang); K.lbi = mag * sinf(ang);
    const float nr = K.lbr - 1.f, ni = K.lbi, den = lre * lre + lim * lim;
    const float cr = (nr * lre + ni * lim) / den, ci = (ni * lre - nr * lim) / den;
    const float* br = P->in[I_BRE] + ((size_t)(layer * 16 + g) * 64 + p) * 16; const float* bi = P->in[I_BIM] + ((size_t)(layer * 16 + g) * 64 + p) * 16;
#pragma unroll
    for (int q4 = 0; q4 < 4; ++q4) {
        const f32x4 r = *(const f32x4*)(br + 4 * q4), i = *(const f32x4*)(bi + 4 * q4);
#pragma unroll
        for (int j = 0; j < 4; ++j) K.bt[q4 * 4 + j] = (f32x2){cr * r[j] - ci * i[j], cr * i[j] + ci * r[j]};
    }
}
__device__ __forceinline__ void s5_step(const S5C& K, const u32x4 ua, const u32x4 ub, float& hre, float& him) {
    float u[16];
    u[0] = bflo(ua.x); u[1] = bfhi(ua.x); u[2] = bflo(ua.y); u[3] = bfhi(ua.y); u[4] = bflo(ua.z); u[5] = bfhi(ua.z); u[6] = bflo(ua.w); u[7] = bfhi(ua.w);
    u[8] = bflo(ub.x); u[9] = bfhi(ub.x); u[10] = bflo(ub.y); u[11] = bfhi(ub.y); u[12] = bflo(ub.z); u[13] = bfhi(ub.z); u[14] = bflo(ub.w); u[15] = bfhi(ub.w);
    f32x2 bu = (f32x2){0.f, 0.f};
#pragma unroll
    for (int c = 0; c < 16; ++c) bu += K.bt[c] * u[c];
    const float nre = K.lbr * hre - K.lbi * him + bu.x, nim = K.lbr * him + K.lbi * hre + bu.y;
    hre = nre; him = nim;
}
__device__ __forceinline__ void s5_end_item(KP P, int layer, int idx, int lane) {
    const int b = idx >> 10, g = (idx >> 6) & 15, k = idx & 63;
    S5C K; s5_consts(P, layer, g, lane, K);
    const bf16_t* up = (const bf16_t*)(P->ws + WS_PROJ) + (size_t)(b * SEQ + k * 128) * PJ + 1536 + g * 16;
    float hre = 0.f, him = 0.f;
#pragma unroll 4
    for (int t = 0; t < 128; ++t) {
        const u32x4 ua = *(const u32x4*)(up + (size_t)t * PJ), ub = *(const u32x4*)(up + (size_t)t * PJ + 8);
        s5_step(K, ua, ub, hre, him);
    }
    f32x2* E = (f32x2*)(P->ws + WS_S5E) + ((size_t)(b * 16 + g) * 64 + k) * 64;
    E[lane] = (f32x2){hre, him};
}
__device__ __forceinline__ void s5_final_item(KP P, int layer, int idx, LAS unsigned char* wlds, int lane) {
    const int b = idx >> 10, g = (idx >> 6) & 15, k = idx & 63, fr = lane & 15, fq = lane >> 4;
    S5C K; s5_consts(P, layer, g, lane, K);
    float tr = K.lbr, ti = K.lbi;
#pragma unroll
    for (int i = 0; i < 7; ++i) { const float a = tr * tr - ti * ti, bq = 2.f * tr * ti; tr = a; ti = bq; }
    float hre = 0.f, him = 0.f;
    const f32x2* E = (const f32x2*)(P->ws + WS_S5E) + ((size_t)(b * 16 + g) * 64) * 64;
    for (int j = 0; j < k; ++j) { const f32x2 e = E[(size_t)j * 64 + lane]; const float nre = tr * hre - ti * him + e.x, nim = tr * him + ti * hre + e.y; hre = nre; him = nim; }
    bf16x8 cfr[4];
    {
        const float* cre = P->in[I_CRE] + ((size_t)(layer * 16 + g) * 16 + fr) * 64; const float* cim = P->in[I_CIM] + ((size_t)(layer * 16 + g) * 16 + fr) * 64;
#pragma unroll
        for (int ks = 0; ks < 4; ++ks) {
            const float* src = (ks < 2 ? cre : cim) + (ks & 1) * 32 + fq * 8; const float sg = ks < 2 ? 1.f : -1.f;
            const f32x4 a = *(const f32x4*)src, c2 = *(const f32x4*)(src + 4);
            u32x4 o; o.x = pk2(sg * a[0], sg * a[1]); o.y = pk2(sg * a[2], sg * a[3]); o.z = pk2(sg * c2[0], sg * c2[1]); o.w = pk2(sg * c2[2], sg * c2[3]);
            cfr[ks] = __builtin_bit_cast(bf16x8, o);
        }
    }
    LAS bf16_t* Hs = (LAS bf16_t*)wlds;
    const bf16_t* up = (const bf16_t*)(P->ws + WS_PROJ) + (size_t)(b * SEQ + k * 128) * PJ + 1536 + g * 16;
    bf16_t* ys = (bf16_t*)(P->ws + WS_YS5) + (size_t)(b * SEQ + k * 128) * 256 + g * 16;
    const float dsk = P->in[I_S5D][layer * 256 + g * 16 + fr];
    for (int tb = 0; tb < 8; ++tb) {
        WAVE_SYNC();
#pragma unroll 4
        for (int t = 0; t < 16; ++t) {
            const u32x4 ua = *(const u32x4*)(up + (size_t)(tb * 16 + t) * PJ), ub = *(const u32x4*)(up + (size_t)(tb * 16 + t) * PJ + 8);
            s5_step(K, ua, ub, hre, him);
            Hs[t * 136 + lane] = (bf16_t)f2bf(hre); Hs[t * 136 + 64 + lane] = (bf16_t)f2bf(him);
        }
        WAVE_SYNC();
        f32x4 acc = (f32x4){0.f, 0.f, 0.f, 0.f};
#pragma unroll
        for (int ks = 0; ks < 4; ++ks) {
            const bf16x8 a = *(const LAS bf16x8*)(Hs + fr * 136 + ks * 32 + fq * 8);
            acc = __builtin_amdgcn_mfma_f32_16x16x32_bf16(a, cfr[ks], acc, 0, 0, 0);
        }
#pragma unroll
        for (int jj = 0; jj < 4; ++jj) {
            const int t = tb * 16 + fq * 4 + jj;
            const float uv = bf2f(up[(size_t)t * PJ + fr]);
            ys[(size_t)t * 256 + fr] = (bf16_t)f2bf(gelu_tanh(acc[jj] + dsk * uv));
        }
    }
}

__device__ __forceinline__ void rg_local_unit(KP P, int layer, int unit, LAS unsigned char* lds, const int tid) {
    const int lane = tid & 63, wave = tid >> 6, fr = lane & 15, fq = lane >> 4;
    const int b = unit >> 7, k = unit & 127;
    const size_t tokb = (size_t)b * SEQ + k * 64;
    LAS float* xcs = (LAS float*)lds;
    LAS float* as_ = (LAS float*)(lds + 32768);
    LAS bf16_t* xcb = (LAS bf16_t*)(lds + 65536);
    const bf16_t* proj = (const bf16_t*)(P->ws + WS_PROJ);
    const bf16_t* rgw = (const bf16_t*)(P->ws + WS_W) + WO_RG;
    const int blk = wave & 3, tt = wave >> 2;
    const int chl = tid & 255, hf = tid >> 8;
    const float* cw = P->in[I_RCW] + (size_t)layer * 1024; const float cbv = P->in[I_RCB][layer * 256 + chl];
    const float w0 = cw[chl], w1 = cw[256 + chl], w2 = cw[512 + chl], w3 = cw[768 + chl];
    float hs = 0.f, Ps = 1.f;
    float sp[4], bav[4], bxv[4];
#pragma unroll
    for (int nt = 0; nt < 4; ++nt) { const int ch = blk * 64 + nt * 16 + fr; sp[nt] = softplusf_(-P->in[I_RLAM][layer * 256 + ch]); bav[nt] = P->in[I_RBA][layer * 256 + ch]; bxv[nt] = P->in[I_RBX][layer * 256 + ch]; }
    float* hloc = (float*)(P->ws + WS_HLOC); float* acum = (float*)(P->ws + WS_ACUM);
    for (int sub = 0; sub < 2; ++sub) {
        __syncthreads();
        {
            const int t0 = sub * 32 + hf * 16;
            const bf16_t* src = proj + (tokb + t0) * PJ + 1792 + chl;
            const bool seq_start = (k == 0) && (t0 == 0);
            float xm3 = 0.f, xm2 = 0.f, xm1 = 0.f;
            if (!seq_start) { xm3 = bf2f(src[-3 * (ptrdiff_t)PJ]); xm2 = bf2f(src[-2 * (ptrdiff_t)PJ]); xm1 = bf2f(src[-1 * (ptrdiff_t)PJ]); }
#pragma unroll
            for (int i8 = 0; i8 < 2; ++i8) {
                float xv[8];
#pragma unroll
                for (int i = 0; i < 8; ++i) xv[i] = bf2f(src[(size_t)(i8 * 8 + i) * PJ]);
#pragma unroll
                for (int i = 0; i < 8; ++i) {
                    const float a3 = i >= 3 ? xv[i - 3] : (i == 0 ? xm3 : (i == 1 ? xm2 : xm1));
                    const float a2 = i >= 2 ? xv[i - 2] : (i == 0 ? xm2 : xm1);
                    const float a1 = i >= 1 ? xv[i - 1] : xm1;
                    const float y = cbv + w0 * a3 + w1 * a2 + w2 * a1 + w3 * xv[i];
                    const int tl = hf * 16 + i8 * 8 + i;
                    xcs[tl * 256 + chl] = y; xcb[tl * 264 + chl] = (bf16_t)f2bf(y);
                }
                xm3 = xv[5]; xm2 = xv[6]; xm1 = xv[7];
            }
        }
        __syncthreads();
        {
            bf16x8 af[2];
#pragma unroll
            for (int ks = 0; ks < 2; ++ks) af[ks] = *(const LAS bf16x8*)(xcb + (tt * 16 + fr) * 264 + blk * 64 + ks * 32 + fq * 8);
            f32x4 gr[4], gi[4];
#pragma unroll
            for (int nt = 0; nt < 4; ++nt) {
                gr[nt] = (f32x4){0.f, 0.f, 0.f, 0.f}; gi[nt] = (f32x4){0.f, 0.f, 0.f, 0.f};
#pragma unroll
                for (int ks = 0; ks < 2; ++ks) {
                    const bf16x8 wr_ = *(const bf16x8*)(rgw + ((size_t)blk * 128 + nt * 16 + fr) * 64 + ks * 32 + fq * 8);
                    const bf16x8 wi_ = *(const bf16x8*)(rgw + ((size_t)blk * 128 + (nt + 4) * 16 + fr) * 64 + ks * 32 + fq * 8);
                    gr[nt] = __builtin_amdgcn_mfma_f32_16x16x32_bf16(af[ks], wr_, gr[nt], 0, 0, 0);
                    gi[nt] = __builtin_amdgcn_mfma_f32_16x16x32_bf16(af[ks], wi_, gi[nt], 0, 0, 0);
                }
            }
#pragma unroll
            for (int nt = 0; nt < 4; ++nt) {
                const int ch = blk * 64 + nt * 16 + fr;
#pragma unroll
                for (int jj = 0; jj < 4; ++jj) {
                    const int tl = tt * 16 + fq * 4 + jj;
                    const float r = sigmoidf_(gr[nt][jj] + bav[nt]), ig = sigmoidf_(gi[nt][jj] + bxv[nt]);
                    const float la = -8.0f * r * sp[nt];
                    const float a = expf(la), mult = sqrtf(-expm1f(2.f * la));
                    const float xc = xcs[tl * 256 + ch];
                    as_[tl * 256 + ch] = a; xcs[tl * 256 + ch] = mult * ig * xc;
                }
            }
        }
        __syncthreads();
        if (tid < 256) {
#pragma unroll 4
            for (int t = 0; t < 32; ++t) {
                const float a = as_[t * 256 + tid], bb = xcs[t * 256 + tid];
                hs = a * hs + bb; Ps *= a;
                const size_t o = (tokb + sub * 32 + t) * 256 + tid;
                hloc[o] = hs; acum[o] = Ps;
            }
        }
    }
    if (tid < 256) {
        ((float*)(P->ws + WS_RGEA))[(size_t)unit * 256 + tid] = Ps;
        ((float*)(P->ws + WS_RGEH))[(size_t)unit * 256 + tid] = hs;
    }
}

__device__ __forceinline__ void rg_final_unit(KP P, int unit, LAS unsigned char* lds, const int tid) {
    const int b = unit >> 7, k = unit & 127;
    LAS float* cs = (LAS float*)lds;
    __syncthreads();
    if (tid < 256) {
        const float* EA = (const float*)(P->ws + WS_RGEA) + (size_t)b * 128 * 256 + tid; const float* EH = (const float*)(P->ws + WS_RGEH) + (size_t)b * 128 * 256 + tid;
        float cr = 0.f;
#pragma unroll 4
        for (int j = 0; j < k; ++j) cr = cr * EA[(size_t)j * 256] + EH[(size_t)j * 256];
        cs[tid] = cr;
    }
    __syncthreads();
    const int ch = tid & 255, hf = tid >> 8;
    const float cr = cs[ch];
    const size_t tokb = (size_t)b * SEQ + k * 64 + hf * 32;
    const float* hloc = (const float*)(P->ws + WS_HLOC); const float* acum = (const float*)(P->ws + WS_ACUM);
    const bf16_t* proj = (const bf16_t*)(P->ws + WS_PROJ); bf16_t* Y = (bf16_t*)(P->ws + WS_Y);
#pragma unroll 4
    for (int t = 0; t < 32; ++t) {
        const size_t tok = tokb + t;
        const float h = hloc[tok * 256 + ch] + acum[tok * 256 + ch] * cr;
        const float gt = bf2f(proj[tok * PJ + 2048 + ch]);
        Y[tok * 1024 + 768 + ch] = (bf16_t)f2bf(h * gelu_tanh(gt));
    }
}

__global__ void __launch_bounds__(NTHR, 2) hybrid_fwd(Params Pv) {
    extern __shared__ __attribute__((aligned(16))) unsigned char lds_raw[];
    LAS unsigned char* lds = (LAS unsigned char*)lds_raw;
    cg::grid_group grid = cg::this_grid();
    KP P;
    { unsigned long long kb = (unsigned long long)__builtin_amdgcn_kernarg_segment_ptr(); asm volatile("" : "+s"(kb)); P = (KP)kb; }
    const int bx = blockIdx.x;
    const int wave0 = __builtin_amdgcn_readfirstlane(threadIdx.x >> 6);

    {
    int G = gridDim.x; asm volatile("" : "+s"(G)); const int NGW = G * NWAVES;
    int tid = wave0 * 64 + (int)__builtin_amdgcn_mbcnt_hi(~0u, __builtin_amdgcn_mbcnt_lo(~0u, 0u)); asm volatile("" : "+v"(tid));
    const int lane = tid & 63, wave = __builtin_amdgcn_readfirstlane(tid >> 6), gw = bx * NWAVES + wave;
    bf16_t* const hb = (bf16_t*)(P->ws + WS_HB);
#if !defined(ONLY) || ONLY==0
    convert_weights(P, 0, lds, gw, NGW, wave, lane);
#endif
    {
        const f32x4* xs = (const f32x4*)P->in[I_X];
        for (size_t i = (size_t)bx * NTHR + tid; i < (size_t)NTOK * DM / 4; i += (size_t)G * NTHR) {
            const f32x4 v = xs[i]; ((f32x4*)P->out)[i] = v; u32x2 w; w.x = pk2(v.x, v.y); w.y = pk2(v.z, v.w); ((u32x2*)hb)[i] = w;
        }
        const f32x4* ms = (const f32x4*)P->in[I_MEM];
        for (size_t i = (size_t)bx * NTHR + tid; i < (size_t)512 * 1024 / 4; i += (size_t)G * NTHR) {
            const f32x4 v = ms[i]; u32x2 w; w.x = pk2(v.x, v.y); w.y = pk2(v.z, v.w); ((u32x2*)(P->ws + WS_MEMB))[i] = w;
        }
    }
    }
    grid.sync();

#pragma nounroll
    for (int ph = 0; ph < 30; ++ph) {
        const int layer = ph / 15, lp = ph % 15;
        { unsigned long long kb = (unsigned long long)__builtin_amdgcn_kernarg_segment_ptr(); asm volatile("" : "+s"(kb)); P = (KP)kb; }
        int G = gridDim.x; asm volatile("" : "+s"(G)); const int NGW = G * NWAVES;
        int tid = wave0 * 64 + (int)__builtin_amdgcn_mbcnt_hi(~0u, __builtin_amdgcn_mbcnt_lo(~0u, 0u)); asm volatile("" : "+v"(tid));
        bf16_t* const W = (bf16_t*)(P->ws + WS_W);
        bf16_t* const hb = (bf16_t*)(P->ws + WS_HB);
        pg8::Sched S; pg8::Epi E;
        S.mode = 0; S.G = G; S.c = bx; S.base = 0; S.nunits = 0; S.A = nullptr; S.B = nullptr; S.tA = 0; S.tB = 0; S.ws = (const char*)P->ws;
        E.mode = 0; E.ws = P->ws; E.o32 = P->out; E.gb = nullptr; E.o16off = 0; E.ldo = 0; E.scale = 1.f; E.act = 0;
        int lda = 1024, ldb = 1024, K = 1024; bool is_gemm = true;
        const size_t T1K = (size_t)256 * 1024 * 2;
        switch (lp) {
        case 0:
            S.mode = 1; S.nunits = 656; S.A = (const char*)hb; S.B = (const char*)(W + WO_IN); S.tA = T1K; S.tB = T1K;
            E.mode = 0;
            break;
        case 3:
            S.nunits = 64; S.A = (const char*)(P->ws + WS_YS5); S.B = (const char*)(W + WO_GLU); S.tA = (size_t)256 * 256 * 2; S.tB = (size_t)256 * 256 * 2; lda = 256; ldb = 256; K = 256;
            E.mode = 4; E.gb = P->in[I_GLUB] + layer * 256;
            break;
        case 5:
            S.nunits = 256; S.A = (const char*)(P->ws + WS_Y); S.B = (const char*)(W + WO_OUT); S.tA = T1K; S.tB = T1K;
            E.mode = 1;
            break;
        case 7:
            S.nunits = 256; S.A = (const char*)hb; S.B = (const char*)(W + WO_Q); S.tA = T1K; S.tB = T1K;
            E.mode = 2; E.o16off = WS_Q; E.ldo = 1024; E.scale = 0.0625f; E.act = 0;
            break;
        case 9:
            S.mode = 3; S.nunits = 256; S.A = (const char*)(P->ws + WS_P); S.B = (const char*)(P->ws + WS_VT); lda = 256; ldb = 256; K = 256;
            E.mode = 3;
            break;
        case 10:
            S.nunits = 256; S.A = (const char*)(P->ws + WS_AO); S.B = (const char*)(W + WO_O); S.tA = T1K; S.tB = T1K;
            E.mode = 1;
            break;
        case 12:
            S.nunits = 1024; S.A = (const char*)hb; S.B = (const char*)(W + WO_W1); S.tA = T1K; S.tB = T1K;
            E.mode = 2; E.o16off = WS_HID; E.ldo = 4096; E.act = 1;
            break;
        case 13:
            S.nunits = 256; S.A = (const char*)(P->ws + WS_HID); S.B = (const char*)(W + WO_W2); S.tA = (size_t)256 * 4096 * 2; S.tB = (size_t)256 * 4096 * 2; lda = 4096; ldb = 4096; K = 4096;
            E.mode = 1;
            break;
        default: is_gemm = false; break;
        }
#if !defined(ONLY) || ONLY==1
        if (is_gemm) pg8::gemm_phase<pg8::Epi, true, true>(lds, lda, ldb, K, S, E, tid);
#endif

        asm volatile("" : "+v"(tid));
        const int lane = tid & 63, wave = __builtin_amdgcn_readfirstlane(tid >> 6), gw = bx * NWAVES + wave;
        LAS unsigned char* wlds = lds + wave * 4608;
        switch (lp) {
        case 1: {
#if !defined(ONLY) || ONLY==2
            for (int u = bx; u < 512; u += G) ssd_prep_unit(P, layer, u >> 2, u & 3, lds, tid);
#endif
#if !defined(ONLY) || ONLY==3
            for (int u = bx; u < 256; u += G) rg_local_unit(P, layer, u, lds, tid);
#endif
#if !defined(ONLY) || ONLY==4
            for (int it = gw; it < 2048; it += NGW) s5_end_item(P, layer, it, lane);
#endif
        } break;
        case 2: {
#if !defined(ONLY) || ONLY==5
            for (int it = gw; it < 2048; it += NGW) ssd_states_item(P, it, wlds, lane);
#endif
#if !defined(ONLY) || ONLY==6
            for (int it = gw; it < 2048; it += NGW) s5_final_item(P, layer, it, wlds, lane);
#endif
        } break;
        case 3: {
            __syncthreads();
#if !defined(ONLY) || ONLY==7
            for (int u = bx; u < 256; u += G) rg_final_unit(P, u, lds, tid);
#endif
            for (int it = (G > 128 ? (bx >= 64 ? (bx - 64) * NWAVES + wave : 1 << 30) : gw); it < 256; it += NGW) ssd_scan_item(P, it, lane);
        } break;
        case 4: {
#if !defined(ONLY) || ONLY==8
            for (int it = gw; it < 1024; it += NGW) ssd_final_item(P, layer, it, wlds, lane);
#endif
        } break;
        case 6: ln_rows(P, P->in[I_LN1G] + layer * 1024, P->in[I_LN1B] + layer * 1024, gw, NGW, lane); break;
        case 8: {
            pg8::Sched S2 = S; S2.mode = 2; S2.nunits = 256; S2.A = (const char*)(P->ws + WS_Q); S2.B = (const char*)(P->ws + WS_KB);
            pg8::EpiSoftmax E2; E2.P = (bf16_t*)(P->ws + WS_P);
#if !defined(ONLY) || ONLY==9
            for (int base = 0; base < 256; base += G) { S2.base = base; S2.nunits = (base + G < 256) ? base + G : 256; int tid2 = tid; asm volatile("" : "+v"(tid2)); pg8::gemm_phase<pg8::EpiSoftmax, false, true>(lds, 1024, 1024, 256, S2, E2, tid2); __syncthreads(); }
#endif
        } break;
        case 11: ln_rows(P, P->in[I_LN2G] + layer * 1024, P->in[I_LN2B] + layer * 1024, gw, NGW, lane); break;
        case 14: {
            ln_rows(P, P->in[I_LN3G] + layer * 1024, P->in[I_LN3B] + layer * 1024, gw, NGW, lane);
            if (layer == 0) { __syncthreads(); convert_weights(P, 1, lds, gw, NGW, wave, lane); }
        } break;
        default: break;
        }
        grid.sync();
    }
}

extern "C" void kernel_launch(void* const* d_in, const int* in_sizes, int n_in, void* d_out, int out_size, void* d_ws, size_t ws_size, hipStream_t stream) {
    static int grid = 0;
    if (grid == 0) {
        if (n_in != 39 || out_size != NTOK * DM || ws_size < WS_END) { fprintf(stderr, "kernel_launch: unexpected shapes (n_in %d out %d ws %zu)\n", n_in, out_size, ws_size); grid = -1; return; }
        int dev = 0, cus = 0, per_cu = 0;
        hipGetDevice(&dev);
        hipDeviceGetAttribute(&cus, hipDeviceAttributeMultiprocessorCount, dev);
        if (hipFuncSetAttribute((const void*)hybrid_fwd, hipFuncAttributeMaxDynamicSharedMemorySize, LDS_BYTES) != hipSuccess) { fprintf(stderr, "kernel_launch: hipFuncSetAttribute failed\n"); grid = -1; return; }
        if (hipOccupancyMaxActiveBlocksPerMultiprocessor(&per_cu, (const void*)hybrid_fwd, NTHR, LDS_BYTES) != hipSuccess || per_cu < 1) { fprintf(stderr, "kernel_launch: occupancy query says %d\n", per_cu); per_cu = 1; }
        (void)hipGetLastError();
        grid = cus;
        if (grid > 256) grid = 256;
    }
    if (grid < 0) return;
    Params p{};
    for (int i = 0; i < 39; ++i) p.in[i] = (const float*)d_in[i];
    p.out = (float*)d_out; p.ws = (unsigned char*)d_ws;
    void* args[] = {&p};
    hipError_t e = hipLaunchCooperativeKernel((const void*)hybrid_fwd, dim3(grid), dim3(NTHR), args, LDS_BYTES, stream);
    if (e != hipSuccess) fprintf(stderr, "cooperative launch failed: %s (grid %d)\n", hipGetErrorString(e), grid);
}
```

```cpp
#include <hip/hip_runtime.h>
#include <hip/hip_cooperative_groups.h>
#include <cstdio>
#include <cstdint>
namespace cg = cooperative_groups;

#define LAS __attribute__((address_space(3)))
typedef unsigned short bf16_t;
typedef short bf16x8 __attribute__((ext_vector_type(8)));
typedef float f32x4 __attribute__((ext_vector_type(4)));
typedef float f32x2 __attribute__((ext_vector_type(2)));
typedef unsigned u32x4 __attribute__((ext_vector_type(4)));
typedef unsigned u32x2 __attribute__((ext_vector_type(2)));

constexpr int NTOK = 16384, DM = 1024, SEQ = 8192, DFF = 4096, DIN = 2312;
constexpr int PJ = 2304;
constexpr int NWAVES = 8, NTHR = 512;
constexpr float LN_EPS = 1e-5f;
constexpr float ALPHA = 1.41421356237f;
constexpr int LDS_BYTES = 131072 + 2048;

constexpr size_t MiB = 1u << 20;
constexpr size_t WS_DT = 0;
constexpr size_t WS_ACS = 512 * 1024;
constexpr size_t WS_S5E = 1 * MiB;
constexpr size_t WS_RGEA = 2 * MiB;
constexpr size_t WS_RGEH = 2 * MiB + 256 * 1024;
constexpr size_t WS_MEMB = 3 * MiB;
constexpr size_t WS_KB = 4 * MiB;
constexpr size_t WS_VT = 5 * MiB;
constexpr size_t WS_CTL = 6 * MiB;
constexpr size_t WS_W = 8 * MiB;
constexpr size_t WS_HB = 40 * MiB;
constexpr size_t WS_XDT = 40 * MiB;
constexpr size_t WS_XN = 56 * MiB;
constexpr size_t WS_BIG = 72 * MiB;
constexpr size_t WS_PROJ = 72 * MiB;
constexpr size_t WS_BN = 144 * MiB;
constexpr size_t WS_BT = 152 * MiB;
constexpr size_t WS_CN = 160 * MiB;
constexpr size_t WS_ST = 168 * MiB;
constexpr size_t WS_YS5 = 184 * MiB;
constexpr size_t WS_HLOC = 192 * MiB;
constexpr size_t WS_ACUM = 208 * MiB;
constexpr size_t WS_Y = 224 * MiB;
constexpr size_t WS_Q = 72 * MiB;
constexpr size_t WS_P = 104 * MiB;
constexpr size_t WS_AO = 136 * MiB;
constexpr size_t WS_HID = 72 * MiB;
constexpr size_t WS_END = 256 * MiB;
constexpr size_t WO_IN = 0, WO_OUT = 2621440, WO_Q = WO_OUT + 1048576, WO_K = WO_Q + 1048576, WO_V = WO_K + 1048576, WO_O = WO_V + 1048576,
                 WO_W1 = WO_O + 1048576, WO_W2 = WO_W1 + 4194304, WO_GLU = WO_W2 + 4194304, WO_RG = WO_GLU + 65536;

__device__ __forceinline__ unsigned f2bf(float f) { unsigned u = __builtin_bit_cast(unsigned, f); return (u + 0x7fffu + ((u >> 16) & 1u)) >> 16; }
__device__ __forceinline__ unsigned pk2(float lo, float hi) { return f2bf(lo) | (f2bf(hi) << 16); }
__device__ __forceinline__ float bf2f(unsigned short b) { return __builtin_bit_cast(float, (unsigned)b << 16); }
__device__ __forceinline__ float bflo(unsigned w) { return __builtin_bit_cast(float, w << 16); }
__device__ __forceinline__ float bfhi(unsigned w) { return __builtin_bit_cast(float, w & 0xffff0000u); }
__device__ __forceinline__ float sigmoidf_(float x) { return 1.0f / (1.0f + __expf(-x)); }
__device__ __forceinline__ float softplusf_(float x) { return x > 20.f ? x : log1pf(expf(x)); }
__device__ __forceinline__ float gelu_tanh(float x) { const float z = 0.7978845608028654f * (x + 0.044715f * x * x * x); const float t = __expf(2.f * z); const float th = 1.f - 2.f / (t + 1.f); return 0.5f * x * (1.f + th); }
__device__ __forceinline__ float shx(float v, int m, int lane) { return __builtin_bit_cast(float, __builtin_amdgcn_ds_bpermute((lane ^ m) << 2, __builtin_bit_cast(int, v))); }
__device__ __forceinline__ float shl_(float v, int src, int) { return __builtin_bit_cast(float, __builtin_amdgcn_ds_bpermute(src << 2, __builtin_bit_cast(int, v))); }
__device__ __forceinline__ float wave_sum(float v, int lane) {
#pragma unroll
    for (int o = 1; o < 64; o <<= 1) v += shx(v, o, lane);
    return v;
}
#define WAVE_SYNC() do { asm volatile("s_waitcnt lgkmcnt(0)" ::: "memory"); __builtin_amdgcn_wave_barrier(); } while (0)

struct Params {
    const float* in[39];
    float* out;
    unsigned char* ws;
};
typedef const __attribute__((address_space(4))) Params* KP;
enum { I_X = 0, I_MEM, I_WIN, I_WOUT, I_SCW, I_SCB, I_SDTB, I_SALOG, I_SD, I_SNW, I_LRE, I_LIM, I_LSTEP, I_BRE, I_BIM, I_CRE, I_CIM, I_S5D, I_GLUW, I_GLUB,
       I_RCW, I_RCB, I_RWA, I_RBA, I_RWX, I_RBX, I_RLAM, I_LN1G, I_LN1B, I_WQ, I_WK, I_WV, I_WO, I_LN2G, I_LN2B, I_W1, I_W2, I_LN3G, I_LN3B };

namespace pg8 {
constexpr int BM = 256, BK = 64, HALF = 128, HTB = HALF * BK * 2, STAGE_BYTES = 8 * HTB;
__device__ __forceinline__ int lds_byte(int r, int c) { const int st = (r >> 4) * 2 + (c >> 5), rr = r & 15, cc = c & 31, ob = rr * 64 + cc * 2; return st * 1024 + (ob ^ (((ob >> 9) & 1) << 5)); }
__device__ __forceinline__ void stage_rc(int b, int& R, int& C) { const int st = b / 1024, sb = b % 1024, swz = sb ^ (((sb >> 9) & 1) << 5); R = (st >> 1) * 16 + swz / 64; C = (st & 1) * 32 + (swz % 64) / 2; }

struct Unit { int pm, pn, kind; };

struct Sched {
    int mode, G, c, base, nunits;
    const char* A; const char* B; size_t tA, tB;
    const char* ws;
    __device__ __forceinline__ bool next(int i, Unit& u) const {
        const int L = base + i * G + c; if (L >= nunits) return false;
        if (mode == 0) { u.pm = (L & 7) * 8 + ((L >> 3) & 7); u.pn = L >> 6; u.kind = 0; }
        else if (mode == 1) {
            if (L < 640) { u.pm = (L & 7) * 8 + ((L >> 3) & 7); u.pn = L >> 6; u.kind = 0; }
            else if (L < 648) { const int j = L - 640; u.pm = j >> 2; u.pn = j & 3; u.kind = 1; }
            else { const int j = L - 648; u.pn = j >> 2; u.pm = j & 3; u.kind = 2; }
        } else { u.pm = L & 31; u.pn = L >> 5; u.kind = 0; }
        return true;
    }
    __device__ __forceinline__ const char* pa(const Unit& u) const {
        if (mode == 0) return A + (size_t)u.pm * tA;
        if (mode == 1) return (u.kind == 0 ? A : (u.kind == 1 ? ws + WS_MEMB : ws + WS_W + WO_V * 2)) + (size_t)u.pm * tA;
        if (mode == 2) return A + ((size_t)((u.pn >> 2) * 8192 + u.pm * 256) * 1024 + (u.pn & 3) * 256) * 2;
        return A + ((size_t)(u.pn * 8192 + u.pm * 256) * 256) * 2;
    }
    __device__ __forceinline__ const char* pb(const Unit& u) const {
        if (mode == 0) return B + (size_t)u.pn * tB;
        if (mode == 1) return (u.kind == 0 ? B : (u.kind == 1 ? ws + WS_W + WO_K * 2 : ws + WS_MEMB)) + (size_t)u.pn * tB;
        if (mode == 2) return B + ((size_t)((u.pn >> 2) * 256) * 1024 + (u.pn & 3) * 256) * 2;
        return B + ((size_t)((u.pn >> 2) * 1024 + (u.pn & 3) * 256) * 256) * 2;
    }
};

__device__ __forceinline__ u32x2 pk4(f32x4 v) { u32x2 w; w.x = pk2(v[0], v[1]); w.y = pk2(v[2], v[3]); return w; }

struct Epi {
    static constexpr bool AFTER_DRAIN = false;
    int mode;
    unsigned char* ws; float* o32; const float* gb; size_t o16off; int ldo; float scale; int act;
    __device__ __forceinline__ void operator()(const f32x4 (&acc)[2][2][4][2], const Unit& u, int wr, int wc, int fr, int fq) const {
        const int rl0 = wr * 64 + fr, cl0 = wc * 32 + 4 * fq;
        if (mode == 1) {
            float* base = o32 + (size_t)(u.pm * BM + rl0) * 1024 + u.pn * BM + cl0;
#pragma unroll
            for (int ai = 0; ai < 2; ++ai)
#pragma unroll
                for (int m = 0; m < 4; ++m) { float* rp = base + (size_t)(ai * HALF + m * 16) * 1024;
#pragma unroll
                    for (int bj = 0; bj < 2; ++bj)
#pragma unroll
                        for (int n = 0; n < 2; ++n) { float* p = rp + bj * HALF + n * 16; const f32x4 b = *(const f32x4*)p; *(f32x4*)p = b * ALPHA + acc[ai][bj][m][n]; }
                    asm volatile("" ::: "memory"); }
        } else if (mode == 4) {
            const bf16_t* ysb = (const bf16_t*)(ws + WS_YS5) + (size_t)(u.pm * BM + rl0) * 256 + cl0;
            bf16_t* yb = (bf16_t*)(ws + WS_Y) + (size_t)(u.pm * BM + rl0) * 1024 + 512 + cl0;
#pragma unroll
            for (int bj = 0; bj < 2; ++bj)
#pragma unroll
                for (int n = 0; n < 2; ++n) { const f32x4 g = *(const f32x4*)(gb + cl0 + bj * HALF + n * 16);
#pragma unroll
                    for (int ai = 0; ai < 2; ++ai)
#pragma unroll
                        for (int m = 0; m < 4; ++m) { const int ro = ai * HALF + m * 16; const f32x4 v = acc[ai][bj][m][n];
                            const u32x2 yw = *(const u32x2*)(ysb + (size_t)ro * 256 + bj * HALF + n * 16);
                            f32x4 o;
                            o[0] = bflo(yw.x) * sigmoidf_(v[0] + g[0]); o[1] = bfhi(yw.x) * sigmoidf_(v[1] + g[1]);
                            o[2] = bflo(yw.y) * sigmoidf_(v[2] + g[2]); o[3] = bfhi(yw.y) * sigmoidf_(v[3] + g[3]);
                            *(u32x2*)(yb + (size_t)ro * 1024 + bj * HALF + n * 16) = pk4(o); if (m & 1) asm volatile("" ::: "memory"); } }
        } else if (mode == 0 && u.kind == 0 && u.pn == 9) {
            if (wc == 0 && fq < 2) {
                float* db = (float*)(ws + WS_DT) + (size_t)(u.pm * BM + rl0) * 8 + 4 * fq;
#pragma unroll
                for (int ai = 0; ai < 2; ++ai)
#pragma unroll
                    for (int m = 0; m < 4; ++m) *(f32x4*)(db + (size_t)(ai * HALF + m * 16) * 8) = acc[ai][0][m][0];
            }
        } else {
            bf16_t* ob; int ld; float sc = 1.f; bool sq = false;
            if (mode == 0) {
                if (u.kind == 0) { ob = (bf16_t*)(ws + WS_PROJ) + (size_t)(u.pm * BM) * PJ + u.pn * BM; ld = PJ; }
                else if (u.kind == 1) { ob = (bf16_t*)(ws + WS_KB) + (size_t)(u.pm * BM) * 1024 + u.pn * BM; ld = 1024; }
                else { ob = (bf16_t*)(ws + WS_VT) + (size_t)(u.pn * 1024 + u.pm * BM) * 256; ld = 256; }
            } else if (mode == 2) { ob = (bf16_t*)(ws + o16off) + (size_t)(u.pm * BM) * ldo + u.pn * BM; ld = ldo; sc = scale; sq = act == 1; }
            else { ob = (bf16_t*)(ws + WS_AO) + (size_t)((u.pn >> 2) * 8192 + u.pm * BM) * 1024 + (u.pn & 3) * 256; ld = 1024; }
            ob += (size_t)rl0 * ld + cl0;
#pragma unroll
            for (int ai = 0; ai < 2; ++ai)
#pragma unroll
                for (int m = 0; m < 4; ++m) { bf16_t* rp = ob + (size_t)(ai * HALF + m * 16) * ld;
#pragma unroll
                    for (int bj = 0; bj < 2; ++bj)
#pragma unroll
                        for (int n = 0; n < 2; ++n) { f32x4 v = acc[ai][bj][m][n];
                            if (sq) { v[0] = fmaxf(v[0], 0.f); v[1] = fmaxf(v[1], 0.f); v[2] = fmaxf(v[2], 0.f); v[3] = fmaxf(v[3], 0.f); v = v * v; } else v = v * sc;
                            *(u32x2*)(rp + bj * HALF + n * 16) = pk4(v); } }
        }
    }
    __device__ __forceinline__ void fused(f32x4 (&)[2][2][4][2], const Unit&, int, int, int, int, LAS unsigned char*, int, int) const {}
};

struct EpiSoftmax {
    static constexpr bool AFTER_DRAIN = true;
    bf16_t* P;
    __device__ __forceinline__ void operator()(const f32x4 (&)[2][2][4][2], const Unit&, int, int, int, int) const {}
    __device__ __forceinline__ void fused(f32x4 (&acc)[2][2][4][2], const Unit& u, int wr, int wc, int fr, int fq, LAS unsigned char* lds, int wid, int lane) const {
        LAS f32x2* X = (LAS f32x2*)lds;
        float mw[2][4];
#pragma unroll
        for (int ai = 0; ai < 2; ++ai)
#pragma unroll
            for (int m = 0; m < 4; ++m) {
                float mx = -3.0e38f;
#pragma unroll
                for (int bj = 0; bj < 2; ++bj)
#pragma unroll
                    for (int n = 0; n < 2; ++n) { const f32x4 x = acc[ai][bj][m][n]; mx = fmaxf(mx, fmaxf(fmaxf(x[0], x[1]), fmaxf(x[2], x[3]))); }
                mx = fmaxf(mx, shx(mx, 16, lane)); mx = fmaxf(mx, shx(mx, 32, lane));
                float s = 0.f;
#pragma unroll
                for (int bj = 0; bj < 2; ++bj)
#pragma unroll
                    for (int n = 0; n < 2; ++n) { f32x4 x = acc[ai][bj][m][n];
                        x[0] = __expf(x[0] - mx); x[1] = __expf(x[1] - mx); x[2] = __expf(x[2] - mx); x[3] = __expf(x[3] - mx);
                        s += (x[0] + x[1]) + (x[2] + x[3]); acc[ai][bj][m][n] = x; }
                s += shx(s, 16, lane); s += shx(s, 32, lane);
                mw[ai][m] = mx;
                if (fq == 0) X[(ai * HALF + wr * 64 + m * 16 + fr) * 4 + wc] = (f32x2){mx, s};
            }
        asm volatile("s_waitcnt lgkmcnt(0)" ::: "memory"); __builtin_amdgcn_s_barrier(); asm volatile("" ::: "memory");
#pragma unroll
        for (int ai = 0; ai < 2; ++ai)
#pragma unroll
            for (int m = 0; m < 4; ++m) {
                const int rl = ai * HALF + wr * 64 + m * 16 + fr;
                const f32x2 a = X[rl * 4 + 0], b = X[rl * 4 + 1], c = X[rl * 4 + 2], d = X[rl * 4 + 3];
                const float M = fmaxf(fmaxf(a.x, b.x), fmaxf(c.x, d.x));
                const float S = a.y * __expf(a.x - M) + b.y * __expf(b.x - M) + c.y * __expf(c.x - M) + d.y * __expf(d.x - M);
                const float f = __expf(mw[ai][m] - M) / S;
#pragma unroll
                for (int bj = 0; bj < 2; ++bj)
#pragma unroll
                    for (int n = 0; n < 2; ++n) {
                        const int cl = bj * HALF + wc * 32 + n * 16 + 4 * fq;
                        *(u32x2*)(P + ((size_t)u.pn * 8192 + u.pm * BM + rl) * 256 + cl) = pk4(acc[ai][bj][m][n] * f);
                    }
            }
        asm volatile("s_waitcnt lgkmcnt(0)" ::: "memory"); __builtin_amdgcn_s_barrier(); asm volatile("" ::: "memory");
    }
};

template <class EpiT, bool ALIGN_EPI, bool SP2>
__device__ __forceinline__ void gemm_phase(LAS unsigned char* lds, const int lda, const int ldb, const int K, const Sched& S, const EpiT& E, const int tid) {
    const int wid = __builtin_amdgcn_readfirstlane(tid >> 6), lane = tid & 63, wr = wid >> 2, wc = wid & 3, fr = lane & 15, fq = lane >> 4;
    const int nt = K / BK;
    unsigned voffA[2], voffB[2];
#pragma unroll
    for (int i = 0; i < 2; ++i) { int R, C; stage_rc(tid * 16 + i * 8192, R, C); voffA[i] = (unsigned)(R * lda + C) * 2u; voffB[i] = (unsigned)(R * ldb + C) * 2u; }
    const size_t kstep = (size_t)(BK * 2);
    const size_t hstepA = (size_t)HALF * lda * 2, hstepB = (size_t)HALF * ldb * 2;
    const unsigned ldsw = (unsigned)wid * 1024u;
    const int aoff = lds_byte(wr * 64 + fr, fq * 8), boff = lds_byte(wc * 32 + fr, fq * 8);
#define PG8_SA(b, h) (((b) * 2 + (h)) * HTB)
#define PG8_SB(b, h) ((4 + (b) * 2 + (h)) * HTB)
#define PG8_STAGE(bufoff, gbase, voff) do { _Pragma("unroll") for (int _i = 0; _i < 2; ++_i) \
        __builtin_amdgcn_global_load_lds((const unsigned*)((const char*)(gbase) + (voff)[_i]), (LAS unsigned*)(lds + (bufoff) + ldsw + _i * 8192), 16, 0, 0); } while (0)
#define PG8_LDA(dst, b, h) do { _Pragma("unroll") for (int m = 0; m < 4; ++m) _Pragma("unroll") for (int k = 0; k < 2; ++k) dst[m][k] = *(const LAS bf16x8*)(lds + PG8_SA(b, h) + aoff + m * 2048 + k * 1024); } while (0)
#define PG8_LDB(dst, b, h) do { _Pragma("unroll") for (int n = 0; n < 2; ++n) _Pragma("unroll") for (int k = 0; k < 2; ++k) dst[n][k] = *(const LAS bf16x8*)(lds + PG8_SB(b, h) + boff + n * 2048 + k * 1024); } while (0)
#define PG8_MMA(ai, bj, At, Bt) do { __builtin_amdgcn_s_setprio(1); _Pragma("unroll") for (int m = 0; m < 4; ++m) _Pragma("unroll") for (int n = 0; n < 2; ++n) _Pragma("unroll") for (int k = 0; k < 2; ++k) \
        acc[ai][bj][m][n] = __builtin_amdgcn_mfma_f32_16x16x32_bf16(Bt[n][k], At[m][k], acc[ai][bj][m][n], 0, 0, 0); __builtin_amdgcn_s_setprio(0); } while (0)
#define PG8_WAIT_V(n) asm volatile("s_waitcnt vmcnt(" #n ")" ::: "memory")
#define PG8_WAIT_L(n) asm volatile("s_waitcnt lgkmcnt(" #n ")" ::: "memory")
#define PG8_BAR __builtin_amdgcn_s_barrier()
#define PG8_SCHED __builtin_amdgcn_sched_barrier(0)
    Unit cur, nxt; int ui = 0;
    if (!S.next(0, cur)) return;
    f32x4 acc[2][2][4][2];
#pragma unroll
    for (int a = 0; a < 2; ++a)
#pragma unroll
        for (int b = 0; b < 2; ++b)
#pragma unroll
            for (int m = 0; m < 4; ++m)
#pragma unroll
                for (int n = 0; n < 2; ++n) acc[a][b][m][n] = (f32x4){0.f, 0.f, 0.f, 0.f};
    bf16x8 At[4][2], B0[2][2], B1[2][2];
    const char* cA = S.pa(cur); const char* cB = S.pb(cur);
    if constexpr (SP2) {
        PG8_STAGE(PG8_SB(0, 0), cB, voffB); PG8_STAGE(PG8_SB(0, 1), cB + hstepB, voffB); PG8_STAGE(PG8_SA(0, 0), cA, voffA); PG8_STAGE(PG8_SA(0, 1), cA + hstepA, voffA);
        if (wr == 1) PG8_BAR;
        PG8_WAIT_V(2); PG8_BAR;
        PG8_STAGE(PG8_SB(1, 0), cB + kstep, voffB); PG8_STAGE(PG8_SA(1, 0), cA + kstep, voffA); PG8_STAGE(PG8_SB(1, 1), cB + hstepB + kstep, voffB);
        PG8_WAIT_V(6); PG8_BAR;
    } else {
        PG8_STAGE(PG8_SB(0, 0), cB, voffB); PG8_STAGE(PG8_SA(0, 0), cA, voffA); PG8_STAGE(PG8_SB(0, 1), cB + hstepB, voffB); PG8_STAGE(PG8_SA(0, 1), cA + hstepA, voffA);
        if (wr == 1) PG8_BAR;
        PG8_WAIT_V(4); PG8_BAR;
        PG8_STAGE(PG8_SB(1, 0), cB + kstep, voffB); PG8_STAGE(PG8_SA(1, 0), cA + kstep, voffA); PG8_STAGE(PG8_SB(1, 1), cB + hstepB + kstep, voffB);
        PG8_WAIT_V(6); PG8_BAR;
    }
    for (;;) {
        const bool has_next = S.next(ui + 1, nxt);
        const char* nA = has_next ? S.pa(nxt) : cA; const char* nB = has_next ? S.pb(nxt) : cB;
        for (int t = 0; t < nt; t += 2) {
            const bool last = (t == nt - 2);
            const char* a1 = cA + (size_t)(t + 1) * kstep;
            const char* a2 = last ? nA : cA + (size_t)(t + 2) * kstep; const char* b2 = last ? nB : cB + (size_t)(t + 2) * kstep;
            const char* a3 = a2 + kstep; const char* b3 = b2 + kstep;
            if constexpr (SP2) {
            PG8_LDB(B0, 0, 0); PG8_LDB(B1, 0, 1); PG8_SCHED; PG8_LDA(At, 0, 0); PG8_STAGE(PG8_SA(1, 1), a1 + hstepA, voffA);
            PG8_WAIT_V(8); PG8_WAIT_L(0); PG8_BAR; PG8_MMA(0, 0, At, B0); PG8_MMA(0, 1, At, B1); PG8_BAR; PG8_SCHED;
            PG8_LDA(At, 0, 1); PG8_STAGE(PG8_SB(0, 0), b2, voffB); PG8_STAGE(PG8_SB(0, 1), b2 + hstepB, voffB); PG8_STAGE(PG8_SA(0, 0), a2, voffA);
            PG8_WAIT_V(8); PG8_WAIT_L(0); PG8_BAR; PG8_MMA(1, 0, At, B0); PG8_MMA(1, 1, At, B1); PG8_BAR; PG8_SCHED;
            PG8_LDB(B0, 1, 0); PG8_LDB(B1, 1, 1); PG8_SCHED; PG8_LDA(At, 1, 0); PG8_STAGE(PG8_SA(0, 1), a2 + hstepA, voffA);
            PG8_WAIT_V(8); PG8_WAIT_L(0); PG8_BAR; PG8_MMA(0, 0, At, B0); PG8_MMA(0, 1, At, B1); PG8_BAR; PG8_SCHED;
            PG8_LDA(At, 1, 1); PG8_STAGE(PG8_SB(1, 0), b3, voffB); PG8_STAGE(PG8_SB(1, 1), b3 + hstepB, voffB); PG8_STAGE(PG8_SA(1, 0), a3, voffA);
            PG8_WAIT_V(8); PG8_WAIT_L(0); PG8_BAR; PG8_MMA(1, 0, At, B0); PG8_MMA(1, 1, At, B1); PG8_BAR; PG8_SCHED;
            } else {
            PG8_LDB(B0, 0, 0); PG8_SCHED; PG8_LDA(At, 0, 0); PG8_STAGE(PG8_SA(1, 1), a1 + hstepA, voffA);
            PG8_WAIT_L(8); PG8_BAR; PG8_WAIT_L(0); PG8_MMA(0, 0, At, B0); PG8_BAR; PG8_SCHED;
            PG8_LDB(B1, 0, 1); PG8_STAGE(PG8_SB(0, 0), b2, voffB);
            PG8_BAR; PG8_WAIT_L(0); PG8_MMA(0, 1, At, B1); PG8_BAR;
            PG8_LDA(At, 0, 1); PG8_STAGE(PG8_SA(0, 0), a2, voffA);
            PG8_BAR; PG8_WAIT_L(0); PG8_MMA(1, 0, At, B0); PG8_BAR; PG8_SCHED;
            PG8_STAGE(PG8_SB(0, 1), b2 + hstepB, voffB);
            PG8_WAIT_V(6); PG8_BAR; PG8_MMA(1, 1, At, B1); PG8_BAR;
            PG8_LDB(B0, 1, 0); PG8_SCHED; PG8_LDA(At, 1, 0); PG8_STAGE(PG8_SA(0, 1), a2 + hstepA, voffA);
            PG8_WAIT_L(8); PG8_BAR; PG8_WAIT_L(0); PG8_MMA(0, 0, At, B0); PG8_BAR; PG8_SCHED;
            PG8_LDB(B1, 1, 1); PG8_STAGE(PG8_SB(1, 0), b3, voffB);
            PG8_BAR; PG8_WAIT_L(0); PG8_MMA(0, 1, At, B1); PG8_BAR;
            PG8_LDA(At, 1, 1); PG8_STAGE(PG8_SA(1, 0), a3, voffA);
            PG8_BAR; PG8_WAIT_L(0); PG8_MMA(1, 0, At, B0); PG8_BAR; PG8_SCHED;
            PG8_STAGE(PG8_SB(1, 1), b3 + hstepB, voffB);
            PG8_WAIT_V(6); PG8_BAR; PG8_MMA(1, 1, At, B1); PG8_BAR;
            }
        }
        if constexpr (ALIGN_EPI) { if (wr == 0) PG8_BAR; }
        if constexpr (!EpiT::AFTER_DRAIN) { E(acc, cur, wr, wc, fr, fq); }
        if (!has_next) break;
#pragma unroll
        for (int a = 0; a < 2; ++a)
#pragma unroll
            for (int b = 0; b < 2; ++b)
#pragma unroll
                for (int m = 0; m < 4; ++m)
#pragma unroll
                    for (int n = 0; n < 2; ++n) acc[a][b][m][n] = (f32x4){0.f, 0.f, 0.f, 0.f};
        cur = nxt; cA = nA; cB = nB; ++ui;
        if constexpr (ALIGN_EPI) { if (wr == 1) PG8_BAR; }
    }
    PG8_WAIT_V(0);
    if constexpr (!ALIGN_EPI) { if (wr == 0) PG8_BAR; }
    PG8_BAR;
    if constexpr (EpiT::AFTER_DRAIN) { E.fused(acc, cur, wr, wc, fr, fq, lds, wid, lane); }
#undef PG8_SA
#undef PG8_SB
#undef PG8_STAGE
#undef PG8_LDA
#undef PG8_LDB
#undef PG8_MMA
#undef PG8_WAIT_V
#undef PG8_WAIT_L
#undef PG8_BAR
#undef PG8_SCHED
}
}

__device__ __forceinline__ void transpose_item(const float* W, int K, int N, bf16_t* WT, LAS float* scr, int kb, int nb, int lane, bool inmap) {
    const int k0 = 64 * kb, n0 = 32 * nb;
    const int dr = n0 + (lane & 31);
    int sc = dr;
    if (inmap) sc = dr < 1536 ? dr : (dr < 2304 ? dr + 8 : (dr < 2312 ? dr - 2304 + 1536 : -1));
#pragma unroll 8
    for (int i = 0; i < 32; ++i) { const int kk = 2 * i + (lane >> 5); scr[kk * 33 + (lane & 31)] = sc >= 0 ? W[(size_t)(k0 + kk) * N + sc] : 0.f; }
    WAVE_SYNC();
    const int c = lane & 7;
#pragma unroll
    for (int j = 0; j < 4; ++j) { const int n = (lane >> 3) + 8 * j; const LAS float* s = scr + (8 * c) * 33 + n;
        u32x4 o; o.x = pk2(s[0 * 33], s[1 * 33]); o.y = pk2(s[2 * 33], s[3 * 33]); o.z = pk2(s[4 * 33], s[5 * 33]); o.w = pk2(s[6 * 33], s[7 * 33]);
        *(u32x4*)(WT + (size_t)(n0 + n) * K + k0 + 8 * c) = o; }
    WAVE_SYNC();
}

__device__ __forceinline__ void convert_weights(KP P, int layer, LAS unsigned char* lds, int gw, int NGW, int wave, int lane) {
    LAS float* scr = (LAS float*)(lds + wave * 8704);
    bf16_t* W = (bf16_t*)(P->ws + WS_W);
    constexpr int I_IN = 16 * 80, I_SQ = 16 * 32, I_1 = 16 * 128, I_2 = 64 * 32, I_G = 4 * 8;
    constexpr int NIT = I_IN + 5 * I_SQ + I_1 + I_2 + I_G;
    for (int it = gw; it < NIT; it += NGW) {
        int r = it;
        if (r < I_IN) { transpose_item(P->in[I_WIN] + (size_t)layer * 1024 * DIN, 1024, DIN, W + WO_IN, scr, r / 80, r % 80, lane, true); continue; } r -= I_IN;
        if (r < I_SQ) { transpose_item(P->in[I_WOUT] + (size_t)layer * 1048576, 1024, 1024, W + WO_OUT, scr, r / 32, r % 32, lane, false); continue; } r -= I_SQ;
        if (r < I_SQ) { transpose_item(P->in[I_WQ] + (size_t)layer * 1048576, 1024, 1024, W + WO_Q, scr, r / 32, r % 32, lane, false); continue; } r -= I_SQ;
        if (r < I_SQ) { transpose_item(P->in[I_WK] + (size_t)layer * 1048576, 1024, 1024, W + WO_K, scr, r / 32, r % 32, lane, false); continue; } r -= I_SQ;
        if (r < I_SQ) { transpose_item(P->in[I_WV] + (size_t)layer * 1048576, 1024, 1024, W + WO_V, scr, r / 32, r % 32, lane, false); continue; } r -= I_SQ;
        if (r < I_SQ) { transpose_item(P->in[I_WO] + (size_t)layer * 1048576, 1024, 1024, W + WO_O, scr, r / 32, r % 32, lane, false); continue; } r -= I_SQ;
        if (r < I_1) { transpose_item(P->in[I_W1] + (size_t)layer * 4194304, 1024, 4096, W + WO_W1, scr, r / 128, r % 128, lane, false); continue; } r -= I_1;
        if (r < I_2) { transpose_item(P->in[I_W2] + (size_t)layer * 4194304, 4096, 1024, W + WO_W2, scr, r / 32, r % 32, lane, false); continue; } r -= I_2;
        transpose_item(P->in[I_GLUW] + (size_t)layer * 65536, 256, 256, W + WO_GLU, scr, r / 8, r % 8, lane, false);
    }
    const float* wa = P->in[I_RWA] + (size_t)layer * 16384; const float* wx = P->in[I_RWX] + (size_t)layer * 16384;
    for (int e = gw * 64 + lane; e < 32768; e += NGW * 64) {
        const int blk = e >> 13, o = (e >> 6) & 127, i = e & 63;
        const float v = o < 64 ? wa[(blk * 64 + i) * 64 + o] : wx[(blk * 64 + i) * 64 + (o - 64)];
        W[WO_RG + e] = (bf16_t)f2bf(v);
    }
}

__device__ __forceinline__ void ln_rows(KP P, const float* g, const float* b, int gw, int NGW, int lane) {
    bf16_t* hb = (bf16_t*)(P->ws + WS_HB);
    f32x4 gv[4], bv[4];
#pragma unroll
    for (int j = 0; j < 4; ++j) { gv[j] = *(const f32x4*)(g + 4 * lane + 256 * j); bv[j] = *(const f32x4*)(b + 4 * lane + 256 * j); }
    for (int r = gw; r < NTOK; r += NGW) {
        f32x4* xr = (f32x4*)(P->out + (size_t)r * DM) + lane;
        f32x4 v[4]; float s = 0.f;
#pragma unroll
        for (int j = 0; j < 4; ++j) { v[j] = xr[64 * j]; s += (v[j].x + v[j].y) + (v[j].z + v[j].w); }
        const float mean = wave_sum(s, lane) * (1.f / DM); float s2 = 0.f;
#pragma unroll
        for (int j = 0; j < 4; ++j) { v[j] = v[j] - mean; s2 += (v[j].x * v[j].x + v[j].y * v[j].y) + (v[j].z * v[j].z + v[j].w * v[j].w); }
        const float rstd = 1.f / sqrtf(wave_sum(s2, lane) * (1.f / DM) + LN_EPS);
        u32x2* o8 = (u32x2*)(hb + (size_t)r * DM) + lane;
#pragma unroll
        for (int j = 0; j < 4; ++j) { const f32x4 o = v[j] * rstd * gv[j] + bv[j]; xr[64 * j] = o; u32x2 w; w.x = pk2(o.x, o.y); w.y = pk2(o.z, o.w); o8[64 * j] = w; }
    }
}

__device__ __forceinline__ void ssd_prep_unit(KP P, int layer, int c, int q, LAS unsigned char* lds, const int tid) {
    const int lane = tid & 63, wave = tid >> 6;
    const int tok0 = c * 128;
    LAS float* dts = (LAS float*)lds;
    const bf16_t* proj = (const bf16_t*)(P->ws + WS_PROJ);
    __syncthreads();
    if (q < 2) {
        const int h = wave;
        const float* dtb = (const float*)(P->ws + WS_DT);
        const float bias = P->in[I_SDTB][layer * 8 + h], a = -expf(P->in[I_SALOG][layer * 8 + h]);
        const float d0 = softplusf_(dtb[(size_t)(tok0 + lane) * 8 + h] + bias), d1 = softplusf_(dtb[(size_t)(tok0 + lane + 64) * 8 + h] + bias);
        dts[h * 128 + lane] = d0; dts[h * 128 + lane + 64] = d1;
        if (q == 0) {
            float s0 = d0 * a, s1 = d1 * a;
#pragma unroll
            for (int d = 1; d < 64; d <<= 1) { const float t0 = shl_(s0, (lane - d) & 63, lane), t1 = shl_(s1, (lane - d) & 63, lane); if (lane >= d) { s0 += t0; s1 += t1; } }
            const float tot0 = shl_(s0, 63 + (lane & 0), lane);
            float* acs = (float*)(P->ws + WS_ACS) + (size_t)(c * 8 + h) * 128;
            acs[lane] = s0; acs[lane + 64] = s1 + tot0;
        }
    }
    __syncthreads();
    const int chl = tid & 255, half = tid >> 8;
    const int xch = q * 256 + chl;
    const float* cw = P->in[I_SCW] + (size_t)layer * 4096; const float cb = P->in[I_SCB][layer * 1024 + xch];
    const float w0 = cw[xch], w1 = cw[1024 + xch], w2 = cw[2048 + xch], w3 = cw[3072 + xch];
    const bf16_t* src = proj + (size_t)tok0 * PJ + 512 + xch;
    const int l0 = half * 64;
    const bool seq_start = ((c & 63) == 0) && (half == 0);
    float xm3 = 0.f, xm2 = 0.f, xm1 = 0.f;
    if (!seq_start) { xm3 = bf2f(src[(ptrdiff_t)(l0 - 3) * PJ]); xm2 = bf2f(src[(ptrdiff_t)(l0 - 2) * PJ]); xm1 = bf2f(src[(ptrdiff_t)(l0 - 1) * PJ]); }
    bf16_t* Xn = (bf16_t*)(P->ws + WS_XN); bf16_t* Xdt = (bf16_t*)(P->ws + WS_XDT);
    bf16_t* Bn = (bf16_t*)(P->ws + WS_BN); bf16_t* Bt = (bf16_t*)(P->ws + WS_BT); bf16_t* Cn = (bf16_t*)(P->ws + WS_CN);
    const int hh = q * 4 + (chl >> 6), pp = chl & 63;
    for (int l8 = 0; l8 < 8; ++l8) {
        const int lb = l0 + l8 * 8;
        float xv[8], ov[8];
#pragma unroll
        for (int i = 0; i < 8; ++i) xv[i] = bf2f(src[(size_t)(lb + i) * PJ]);
#pragma unroll
        for (int i = 0; i < 8; ++i) {
            const float a3 = i >= 3 ? xv[i - 3] : (i == 0 ? xm3 : (i == 1 ? xm2 : xm1));
            const float a2 = i >= 2 ? xv[i - 2] : (i == 0 ? xm2 : xm1);
            const float a1 = i >= 1 ? xv[i - 1] : xm1;
            const float y = cb + w0 * a3 + w1 * a2 + w2 * a1 + w3 * xv[i];
            ov[i] = y * sigmoidf_(y);
        }
        xm3 = xv[5]; xm2 = xv[6]; xm1 = xv[7];
        if (q < 2) {
#pragma unroll
            for (int i = 0; i < 8; ++i) Xn[(size_t)(tok0 + lb + i) * 512 + xch] = (bf16_t)f2bf(ov[i]);
            float dv[8];
#pragma unroll
            for (int i = 0; i < 8; ++i) dv[i] = ov[i] * dts[hh * 128 + lb + i];
            u32x4 o; o.x = pk2(dv[0], dv[1]); o.y = pk2(dv[2], dv[3]); o.z = pk2(dv[4], dv[5]); o.w = pk2(dv[6], dv[7]);
            *(u32x4*)(Xdt + ((size_t)(c * 8 + hh) * 64 + pp) * 128 + lb) = o;
        } else if (q == 2) {
#pragma unroll
            for (int i = 0; i < 8; ++i) Bn[(size_t)(tok0 + lb + i) * 256 + chl] = (bf16_t)f2bf(ov[i]);
            u32x4 o; o.x = pk2(ov[0], ov[1]); o.y = pk2(ov[2], ov[3]); o.z = pk2(ov[4], ov[5]); o.w = pk2(ov[6], ov[7]);
            *(u32x4*)(Bt + ((size_t)(c * 2 + (chl >> 7)) * 128 + (chl & 127)) * 128 + lb) = o;
        } else {
#pragma unroll
            for (int i = 0; i < 8; ++i) Cn[(size_t)(tok0 + lb + i) * 256 + chl] = (bf16_t)f2bf(ov[i]);
        }
    }
}

__device__ __forceinline__ void ssd_states_item(KP P, int idx, LAS unsigned char* wlds, int lane) {
    const int c = idx >> 4, h = (idx >> 1) & 7, nh = idx & 1, g = h >> 2, fr = lane & 15, fq = lane >> 4;
    LAS float* dec = (LAS float*)wlds;
    const float* acs = (const float*)(P->ws + WS_ACS) + (size_t)(c * 8 + h) * 128;
    const float aend = acs[127];
    WAVE_SYNC();
    dec[lane] = __expf(aend - acs[lane]); dec[lane + 64] = __expf(aend - acs[lane + 64]);
    WAVE_SYNC();
    const bf16_t* Xdt = (const bf16_t*)(P->ws + WS_XDT) + (size_t)(c * 8 + h) * 64 * 128;
    const bf16_t* Bt = (const bf16_t*)(P->ws + WS_BT) + ((size_t)(c * 2 + g) * 128 + nh * 64) * 128;
    f32x4 acc[4][4];
#pragma unroll
    for (int a = 0; a < 4; ++a)
#pragma unroll
        for (int b = 0; b < 4; ++b) acc[a][b] = (f32x4){0.f, 0.f, 0.f, 0.f};
#pragma unroll
    for (int ks = 0; ks < 4; ++ks) {
        const f32x4 d0 = *(const LAS f32x4*)(dec + ks * 32 + fq * 8), d1 = *(const LAS f32x4*)(dec + ks * 32 + fq * 8 + 4);
        bf16x8 af[4], bfr[4];
#pragma unroll
        for (int pt = 0; pt < 4; ++pt) {
            const u32x4 raw = *(const u32x4*)(Xdt + (size_t)(pt * 16 + fr) * 128 + ks * 32 + fq * 8);
            u32x4 o;
            o.x = pk2(bflo(raw.x) * d0[0], bfhi(raw.x) * d0[1]); o.y = pk2(bflo(raw.y) * d0[2], bfhi(raw.y) * d0[3]);
            o.z = pk2(bflo(raw.z) * d1[0], bfhi(raw.z) * d1[1]); o.w = pk2(bflo(raw.w) * d1[2], bfhi(raw.w) * d1[3]);
            af[pt] = __builtin_bit_cast(bf16x8, o);
        }
#pragma unroll
        for (int nt = 0; nt < 4; ++nt) bfr[nt] = *(const bf16x8*)(Bt + (size_t)(nt * 16 + fr) * 128 + ks * 32 + fq * 8);
#pragma unroll
        for (int pt = 0; pt < 4; ++pt)
#pragma unroll
            for (int nt = 0; nt < 4; ++nt) acc[pt][nt] = __builtin_amdgcn_mfma_f32_16x16x32_bf16(af[pt], bfr[nt], acc[pt][nt], 0, 0, 0);
    }
    bf16_t* st = (bf16_t*)(P->ws + WS_ST) + (size_t)(c * 8 + h) * 64 * 128 + nh * 64;
#pragma unroll
    for (int pt = 0; pt < 4; ++pt)
#pragma unroll
        for (int nt = 0; nt < 4; ++nt)
#pragma unroll
            for (int jj = 0; jj < 4; ++jj) st[(size_t)(pt * 16 + fq * 4 + jj) * 128 + nt * 16 + fr] = (bf16_t)f2bf(acc[pt][nt][jj]);
}

__device__ __forceinline__ void ssd_scan_item(KP P, int idx, int lane) {
    const int tix = idx * 64 + lane;
    const int b = tix >> 13, rem = tix & 8191, h = rem >> 10, p = (rem >> 4) & 63, n8 = rem & 15;
    float run[8];
#pragma unroll
    for (int i = 0; i < 8; ++i) run[i] = 0.f;
    const float* acs = (const float*)(P->ws + WS_ACS);
    bf16_t* st = (bf16_t*)(P->ws + WS_ST);
#pragma unroll 4
    for (int cc = 0; cc < 64; ++cc) {
        const int c = b * 64 + cc;
        u32x4* ptr = (u32x4*)(st + ((size_t)(c * 8 + h) * 64 + p) * 128 + n8 * 8);
        const u32x4 s = *ptr;
        const float dec = __expf(acs[(size_t)(c * 8 + h) * 128 + 127]);
        u32x4 o; o.x = pk2(run[0], run[1]); o.y = pk2(run[2], run[3]); o.z = pk2(run[4], run[5]); o.w = pk2(run[6], run[7]);
        *ptr = o;
        run[0] = run[0] * dec + bflo(s.x); run[1] = run[1] * dec + bfhi(s.x); run[2] = run[2] * dec + bflo(s.y); run[3] = run[3] * dec + bfhi(s.y);
        run[4] = run[4] * dec + bflo(s.z); run[5] = run[5] * dec + bfhi(s.z); run[6] = run[6] * dec + bflo(s.w); run[7] = run[7] * dec + bfhi(s.w);
    }
}

__device__ __forceinline__ void ssd_final_item(KP P, int layer, int idx, LAS unsigned char* wlds, int lane) {
    const int c = idx >> 3, lt = idx & 7, fr = lane & 15, fq = lane >> 4;
    const int tok0 = c * 128;
    LAS bf16_t* Ms = (LAS bf16_t*)wlds;
    const bf16_t* proj = (const bf16_t*)(P->ws + WS_PROJ);
    const bf16_t* Xn = (const bf16_t*)(P->ws + WS_XN);
    const bf16_t* Cn = (const bf16_t*)(P->ws + WS_CN);
    const bf16_t* Bn = (const bf16_t*)(P->ws + WS_BN);
    bf16_t* Y = (bf16_t*)(P->ws + WS_Y);
    float ssq[4] = {0.f, 0.f, 0.f, 0.f};
#pragma nounroll
    for (int g = 0; g < 2; ++g) {
        bf16x8 cf[4];
#pragma unroll
        for (int ks = 0; ks < 4; ++ks) cf[ks] = *(const bf16x8*)(Cn + (size_t)(tok0 + lt * 16 + fr) * 256 + g * 128 + ks * 32 + fq * 8);
        f32x4 cb[8];
#pragma unroll
        for (int st = 0; st < 8; ++st) {
            cb[st] = (f32x4){0.f, 0.f, 0.f, 0.f};
#pragma unroll
            for (int ks = 0; ks < 4; ++ks) {
                const bf16x8 bb = *(const bf16x8*)(Bn + (size_t)(tok0 + st * 16 + fr) * 256 + g * 128 + ks * 32 + fq * 8);
                cb[st] = __builtin_amdgcn_mfma_f32_16x16x32_bf16(cf[ks], bb, cb[st], 0, 0, 0);
            }
            if (st & 1) asm volatile("" ::: "memory");
        }
#pragma nounroll
        for (int hh = 0; hh < 4; ++hh) {
            const int h = g * 4 + hh;
            const float* ac = (const float*)(P->ws + WS_ACS) + (size_t)(c * 8 + h) * 128;
            float al[4];
#pragma unroll
            for (int jj = 0; jj < 4; ++jj) al[jj] = ac[lt * 16 + fq * 4 + jj];
            WAVE_SYNC();
#pragma unroll
            for (int st = 0; st < 8; ++st) {
                const float as_ = ac[st * 16 + fr];
                const int s = st * 16 + fr;
#pragma unroll
                for (int jj = 0; jj < 4; ++jj) {
                    const int l = lt * 16 + fq * 4 + jj;
                    const float v = (s <= l) ? cb[st][jj] * __expf(al[jj] - as_) : 0.f;
                    Ms[(fq * 4 + jj) * 136 + s] = (bf16_t)f2bf(v);
                }
            }
            WAVE_SYNC();
            bf16x8 mf[4];
#pragma unroll
            for (int ks = 0; ks < 4; ++ks) mf[ks] = *(const LAS bf16x8*)(Ms + fr * 136 + ks * 32 + fq * 8);
            const bf16_t* Xdt = (const bf16_t*)(P->ws + WS_XDT) + (size_t)(c * 8 + h) * 64 * 128;
            const bf16_t* prev = (const bf16_t*)(P->ws + WS_ST) + (size_t)(c * 8 + h) * 64 * 128;
            const float Dh = P->in[I_SD][layer * 8 + h];
#pragma nounroll
            for (int pt = 0; pt < 4; ++pt) {
                f32x4 ad = (f32x4){0.f, 0.f, 0.f, 0.f}, ao = (f32x4){0.f, 0.f, 0.f, 0.f};
#pragma unroll
                for (int ks = 0; ks < 4; ++ks) {
                    const bf16x8 bx = *(const bf16x8*)(Xdt + (size_t)(pt * 16 + fr) * 128 + ks * 32 + fq * 8);
                    ad = __builtin_amdgcn_mfma_f32_16x16x32_bf16(mf[ks], bx, ad, 0, 0, 0);
                }
#pragma unroll
                for (int ks = 0; ks < 4; ++ks) {
                    const bf16x8 bp = *(const bf16x8*)(prev + (size_t)(pt * 16 + fr) * 128 + ks * 32 + fq * 8);
                    ao = __builtin_amdgcn_mfma_f32_16x16x32_bf16(cf[ks], bp, ao, 0, 0, 0);
                }
                const int ch = h * 64 + pt * 16 + fr;
#pragma unroll
                for (int jj = 0; jj < 4; ++jj) {
                    const size_t tok = (size_t)(tok0 + lt * 16 + fq * 4 + jj);
                    const float xv = bf2f(Xn[tok * 512 + ch]);
                    const float zv = bf2f(proj[tok * PJ + ch]);
                    float y = ad[jj] + __expf(al[jj]) * ao[jj] + Dh * xv;
                    y *= zv * sigmoidf_(zv);
                    const unsigned yb = f2bf(y); const float yr = bf2f((unsigned short)yb);
                    Y[tok * 1024 + ch] = (bf16_t)yb; ssq[jj] += yr * yr;
                }
            }
        }
    }
    float rstd[4];
#pragma unroll
    for (int jj = 0; jj < 4; ++jj) { float s = ssq[jj]; s += shx(s, 1, lane); s += shx(s, 2, lane); s += shx(s, 4, lane); s += shx(s, 8, lane); rstd[jj] = 1.f / sqrtf(s * (1.f / 512.f) + LN_EPS); }
    const float* nw = P->in[I_SNW] + layer * 512;
    asm volatile("s_waitcnt vmcnt(0)" ::: "memory");
#pragma nounroll
    for (int h = 0; h < 8; ++h)
#pragma unroll
        for (int pt = 0; pt < 4; ++pt) {
            const int ch = h * 64 + pt * 16 + fr; const float w = nw[ch];
#pragma unroll
            for (int jj = 0; jj < 4; ++jj) { bf16_t* yp = Y + (size_t)(tok0 + lt * 16 + fq * 4 + jj) * 1024 + ch; *yp = (bf16_t)f2bf(bf2f(*yp) * rstd[jj] * w); }
        }
}

struct S5C { float lbr, lbi; f32x2 bt[16]; };
__device__ __forceinline__ void s5_consts(KP P, int layer, int g, int p, S5C& K) {
    const float lre = P->in[I_LRE][(layer * 16 + g) * 64 + p], lim = P->in[I_LIM][(layer * 16 + g) * 64 + p];
    const float step = expf(P->in[I_LSTEP][layer * 16 + g]);
    const float mag = expf(lre * step), ang = lim * step;
    K.lbr = mag * cosf(ang); K.lbi = mag * sinf(ang);
    const float nr = K.lbr - 1.f, ni = K.lbi, den = lre * lre + lim * lim;
    const float cr = (nr * lre + ni * lim) / den, ci = (ni * lre - nr * lim) / den;
    const float* br = P->in[I_BRE] + ((size_t)(layer * 16 + g) * 64 + p) * 16; const float* bi = P->in[I_BIM] + ((size_t)(layer * 16 + g) * 64 + p) * 16;
#pragma unroll
    for (int q4 = 0; q4 < 4; ++q4) {
        const f32x4 r = *(const f32x4*)(br + 4 * q4), i = *(const f32x4*)(bi + 4 * q4);
#pragma unroll
        for (int j = 0; j < 4; ++j) K.bt[q4 * 4 + j] = (f32x2){cr * r[j] - ci * i[j], cr * i[j] + ci * r[j]};
    }
}
__device__ __forceinline__ void s5_step(const S5C& K, const u32x4 ua, const u32x4 ub, float& hre, float& him) {
    float u[16];
    u[0] = bflo(ua.x); u[1] = bfhi(ua.x); u[2] = bflo(ua.y); u[3] = bfhi(ua.y); u[4] = bflo(ua.z); u[5] = bfhi(ua.z); u[6] = bflo(ua.w); u[7] = bfhi(ua.w);
    u[8] = bflo(ub.x); u[9] = bfhi(ub.x); u[10] = bflo(ub.y); u[11] = bfhi(ub.y); u[12] = bflo(ub.z); u[13] = bfhi(ub.z); u[14] = bflo(ub.w); u[15] = bfhi(ub.w);
    f32x2 bu = (f32x2){0.f, 0.f};
#pragma unroll
    for (int c = 0; c < 16; ++c) bu += K.bt[c] * u[c];
    const float nre = K.lbr * hre - K.lbi * him + bu.x, nim = K.lbr * him + K.lbi * hre + bu.y;
    hre = nre; him = nim;
}
__device__ __forceinline__ void s5_end_item(KP P, int layer, int idx, int lane) {
    const int b = idx >> 10, g = (idx >> 6) & 15, k = idx & 63;
    S5C K; s5_consts(P, layer, g, lane, K);
    const bf16_t* up = (const bf16_t*)(P->ws + WS_PROJ) + (size_t)(b * SEQ + k * 128) * PJ + 1536 + g * 16;
    float hre = 0.f, him = 0.f;
#pragma unroll 4
    for (int t = 0; t < 128; ++t) {
        const u32x4 ua = *(const u32x4*)(up + (size_t)t * PJ), ub = *(const u32x4*)(up + (size_t)t * PJ + 8);
        s5_step(K, ua, ub, hre, him);
    }
    f32x2* E = (f32x2*)(P->ws + WS_S5E) + ((size_t)(b * 16 + g) * 64 + k) * 64;
    E[lane] = (f32x2){hre, him};
}
__device__ __forceinline__ void s5_final_item(KP P, int layer, int idx, LAS unsigned char* wlds, int lane) {
    const int b = idx >> 10, g = (idx >> 6) & 15, k = idx & 63, fr = lane & 15, fq = lane >> 4;
    S5C K; s5_consts(P, layer, g, lane, K);
    float tr = K.lbr, ti = K.lbi;
#pragma unroll
    for (int i = 0; i < 7; ++i) { const float a = tr * tr - ti * ti, bq = 2.f * tr * ti; tr = a; ti = bq; }
    float hre = 0.f, him = 0.f;
    const f32x2* E = (const f32x2*)(P->ws + WS_S5E) + ((size_t)(b * 16 + g) * 64) * 64;
    for (int j = 0; j < k; ++j) { const f32x2 e = E[(size_t)j * 64 + lane]; const float nre = tr * hre - ti * him + e.x, nim = tr * him + ti * hre + e.y; hre = nre; him = nim; }
    bf16x8 cfr[4];
    {
        const float* cre = P->in[I_CRE] + ((size_t)(layer * 16 + g) * 16 + fr) * 64; const float* cim = P->in[I_CIM] + ((size_t)(layer * 16 + g) * 16 + fr) * 64;
#pragma unroll
        for (int ks = 0; ks < 4; ++ks) {
            const float* src = (ks < 2 ? cre : cim) + (ks & 1) * 32 + fq * 8; const float sg = ks < 2 ? 1.f : -1.f;
            const f32x4 a = *(const f32x4*)src, c2 = *(const f32x4*)(src + 4);
            u32x4 o; o.x = pk2(sg * a[0], sg * a[1]); o.y = pk2(sg * a[2], sg * a[3]); o.z = pk2(sg * c2[0], sg * c2[1]); o.w = pk2(sg * c2[2], sg * c2[3]);
            cfr[ks] = __builtin_bit_cast(bf16x8, o);
        }
    }
    LAS bf16_t* Hs = (LAS bf16_t*)wlds;
    const bf16_t* up = (const bf16_t*)(P->ws + WS_PROJ) + (size_t)(b * SEQ + k * 128) * PJ + 1536 + g * 16;
    bf16_t* ys = (bf16_t*)(P->ws + WS_YS5) + (size_t)(b * SEQ + k * 128) * 256 + g * 16;
    const float dsk = P->in[I_S5D][layer * 256 + g * 16 + fr];
    for (int tb = 0; tb < 8; ++tb) {
        WAVE_SYNC();
#pragma unroll 4
        for (int t = 0; t < 16; ++t) {
            const u32x4 ua = *(const u32x4*)(up + (size_t)(tb * 16 + t) * PJ), ub = *(const u32x4*)(up + (size_t)(tb * 16 + t) * PJ + 8);
            s5_step(K, ua, ub, hre, him);
            Hs[t * 136 + lane] = (bf16_t)f2bf(hre); Hs[t * 136 + 64 + lane] = (bf16_t)f2bf(him);
        }
        WAVE_SYNC();
        f32x4 acc = (f32x4){0.f, 0.f, 0.f, 0.f};
#pragma unroll
        for (int ks = 0; ks < 4; ++ks) {
            const bf16x8 a = *(const LAS bf16x8*)(Hs + fr * 136 + ks * 32 + fq * 8);
            acc = __builtin_amdgcn_mfma_f32_16x16x32_bf16(a, cfr[ks], acc, 0, 0, 0);
        }
#pragma unroll
        for (int jj = 0; jj < 4; ++jj) {
            const int t = tb * 16 + fq * 4 + jj;
            const float uv = bf2f(up[(size_t)t * PJ + fr]);
            ys[(size_t)t * 256 + fr] = (bf16_t)f2bf(gelu_tanh(acc[jj] + dsk * uv));
        }
    }
}

__device__ __forceinline__ void rg_local_unit(KP P, int layer, int unit, LAS unsigned char* lds, const int tid) {
    const int lane = tid & 63, wave = tid >> 6, fr = lane & 15, fq = lane >> 4;
    const int b = unit >> 7, k = unit & 127;
    const size_t tokb = (size_t)b * SEQ + k * 64;
    LAS float* xcs = (LAS float*)lds;
    LAS float* as_ = (LAS float*)(lds + 32768);
    LAS bf16_t* xcb = (LAS bf16_t*)(lds + 65536);
    const bf16_t* proj = (const bf16_t*)(P->ws + WS_PROJ);
    const bf16_t* rgw = (const bf16_t*)(P->ws + WS_W) + WO_RG;
    const int blk = wave & 3, tt = wave >> 2;
    const int chl = tid & 255, hf = tid >> 8;
    const float* cw = P->in[I_RCW] + (size_t)layer * 1024; const float cbv = P->in[I_RCB][layer * 256 + chl];
    const float w0 = cw[chl], w1 = cw[256 + chl], w2 = cw[512 + chl], w3 = cw[768 + chl];
    float hs = 0.f, Ps = 1.f;
    float sp[4], bav[4], bxv[4];
#pragma unroll
    for (int nt = 0; nt < 4; ++nt) { const int ch = blk * 64 + nt * 16 + fr; sp[nt] = softplusf_(-P->in[I_RLAM][layer * 256 + ch]); bav[nt] = P->in[I_RBA][layer * 256 + ch]; bxv[nt] = P->in[I_RBX][layer * 256 + ch]; }
    float* hloc = (float*)(P->ws + WS_HLOC); float* acum = (float*)(P->ws + WS_ACUM);
    for (int sub = 0; sub < 2; ++sub) {
        __syncthreads();
        {
            const int t0 = sub * 32 + hf * 16;
            const bf16_t* src = proj + (tokb + t0) * PJ + 1792 + chl;
            const bool seq_start = (k == 0) && (t0 == 0);
            float xm3 = 0.f, xm2 = 0.f, xm1 = 0.f;
            if (!seq_start) { xm3 = bf2f(src[-3 * (ptrdiff_t)PJ]); xm2 = bf2f(src[-2 * (ptrdiff_t)PJ]); xm1 = bf2f(src[-1 * (ptrdiff_t)PJ]); }
#pragma unroll
            for (int i8 = 0; i8 < 2; ++i8) {
                float xv[8];
#pragma unroll
                for (int i = 0; i < 8; ++i) xv[i] = bf2f(src[(size_t)(i8 * 8 + i) * PJ]);
#pragma unroll
                for (int i = 0; i < 8; ++i) {
                    const float a3 = i >= 3 ? xv[i - 3] : (i == 0 ? xm3 : (i == 1 ? xm2 : xm1));
                    const float a2 = i >= 2 ? xv[i - 2] : (i == 0 ? xm2 : xm1);
                    const float a1 = i >= 1 ? xv[i - 1] : xm1;
                    const float y = cbv + w0 * a3 + w1 * a2 + w2 * a1 + w3 * xv[i];
                    const int tl = hf * 16 + i8 * 8 + i;
                    xcs[tl * 256 + chl] = y; xcb[tl * 264 + chl] = (bf16_t)f2bf(y);
                }
                xm3 = xv[5]; xm2 = xv[6]; xm1 = xv[7];
            }
        }
        __syncthreads();
        {
            bf16x8 af[2];
#pragma unroll
            for (int ks = 0; ks < 2; ++ks) af[ks] = *(const LAS bf16x8*)(xcb + (tt * 16 + fr) * 264 + blk * 64 + ks * 32 + fq * 8);
            f32x4 gr[4], gi[4];
#pragma unroll
            for (int nt = 0; nt < 4; ++nt) {
                gr[nt] = (f32x4){0.f, 0.f, 0.f, 0.f}; gi[nt] = (f32x4){0.f, 0.f, 0.f, 0.f};
#pragma unroll
                for (int ks = 0; ks < 2; ++ks) {
                    const bf16x8 wr_ = *(const bf16x8*)(rgw + ((size_t)blk * 128 + nt * 16 + fr) * 64 + ks * 32 + fq * 8);
                    const bf16x8 wi_ = *(const bf16x8*)(rgw + ((size_t)blk * 128 + (nt + 4) * 16 + fr) * 64 + ks * 32 + fq * 8);
                    gr[nt] = __builtin_amdgcn_mfma_f32_16x16x32_bf16(af[ks], wr_, gr[nt], 0, 0, 0);
                    gi[nt] = __builtin_amdgcn_mfma_f32_16x16x32_bf16(af[ks], wi_, gi[nt], 0, 0, 0);
                }
            }
#pragma unroll
            for (int nt = 0; nt < 4; ++nt) {
                const int ch = blk * 64 + nt * 16 + fr;
#pragma unroll
                for (int jj = 0; jj < 4; ++jj) {
                    const int tl = tt * 16 + fq * 4 + jj;
                    const float r = sigmoidf_(gr[nt][jj] + bav[nt]), ig = sigmoidf_(gi[nt][jj] + bxv[nt]);
                    const float la = -8.0f * r * sp[nt];
                    const float a = expf(la), mult = sqrtf(-expm1f(2.f * la));
                    const float xc = xcs[tl * 256 + ch];
                    as_[tl * 256 + ch] = a; xcs[tl * 256 + ch] = mult * ig * xc;
                }
            }
        }
        __syncthreads();
        if (tid < 256) {
#pragma unroll 4
            for (int t = 0; t < 32; ++t) {
                const float a = as_[t * 256 + tid], bb = xcs[t * 256 + tid];
                hs = a * hs + bb; Ps *= a;
                const size_t o = (tokb + sub * 32 + t) * 256 + tid;
                hloc[o] = hs; acum[o] = Ps;
            }
        }
    }
    if (tid < 256) {
        ((float*)(P->ws + WS_RGEA))[(size_t)unit * 256 + tid] = Ps;
        ((float*)(P->ws + WS_RGEH))[(size_t)unit * 256 + tid] = hs;
    }
}

__device__ __forceinline__ void rg_final_unit(KP P, int unit, LAS unsigned char* lds, const int tid) {
    const int b = unit >> 7, k = unit & 127;
    LAS float* cs = (LAS float*)lds;
    __syncthreads();
    if (tid < 256) {
        const float* EA = (const float*)(P->ws + WS_RGEA) + (size_t)b * 128 * 256 + tid; const float* EH = (const float*)(P->ws + WS_RGEH) + (size_t)b * 128 * 256 + tid;
        float cr = 0.f;
#pragma unroll 4
        for (int j = 0; j < k; ++j) cr = cr * EA[(size_t)j * 256] + EH[(size_t)j * 256];
        cs[tid] = cr;
    }
    __syncthreads();
    const int ch = tid & 255, hf = tid >> 8;
    const float cr = cs[ch];
    const size_t tokb = (size_t)b * SEQ + k * 64 + hf * 32;
    const float* hloc = (const float*)(P->ws + WS_HLOC); const float* acum = (const float*)(P->ws + WS_ACUM);
    const bf16_t* proj = (const bf16_t*)(P->ws + WS_PROJ); bf16_t* Y = (bf16_t*)(P->ws + WS_Y);
#pragma unroll 4
    for (int t = 0; t < 32; ++t) {
        const size_t tok = tokb + t;
        const float h = hloc[tok * 256 + ch] + acum[tok * 256 + ch] * cr;
        const float gt = bf2f(proj[tok * PJ + 2048 + ch]);
        Y[tok * 1024 + 768 + ch] = (bf16_t)f2bf(h * gelu_tanh(gt));
    }
}


#define XB_TMO      128
#define XB_XCNT(j)  (256  + 64 * (j))
#define XB_XSUB(j)  (1280 + 64 * (j))
#define XB_XGEN(j)  (2304 + 64 * (j))
#define XB_TOP      3328
#define XB_TOPGEN   3392
#define XCD_BAR_WORDS 3456
#define XB_SPIN_CAP (1u << 18)
__device__ __forceinline__ unsigned xb_ld(unsigned* p)              { return __hip_atomic_load(p, __ATOMIC_RELAXED, __HIP_MEMORY_SCOPE_AGENT); }
__device__ __forceinline__ unsigned xb_add(unsigned* p, unsigned v) { return __hip_atomic_fetch_add(p, v, __ATOMIC_RELAXED, __HIP_MEMORY_SCOPE_AGENT); }
__device__ __forceinline__ unsigned xb_xcc_id() { return (unsigned)__builtin_amdgcn_s_getreg((3 << 11) | 20) & 0xFu; }
#define XB_SPIN(cond, bar) do { unsigned _sp = 0; while (cond) { __builtin_amdgcn_s_sleep(1); \
    if ((++_sp & 255u) == 0u) { if (xb_ld(&(bar)[XB_TMO])) break; if (_sp > XB_SPIN_CAP) { atomicAdd(&(bar)[XB_TMO], 1u); break; } } } } while (0)
struct XcdBarrier { unsigned* bar; unsigned x; volatile LAS unsigned* st; };
__device__ __forceinline__ void xcd_barrier_complete(unsigned* bar, unsigned x, unsigned& nloc, unsigned& nx) {
    const unsigned G = gridDim.x * gridDim.y * gridDim.z;
    unsigned sum, cnt, mine, sp = 0u;
    for (;;) {
        sum = 0u; cnt = 0u; mine = 0u;
#pragma unroll
        for (unsigned j = 0; j < 16; ++j) { const unsigned c = xb_ld(&bar[XB_XCNT(j)]); sum += c; cnt += (c > 0u) ? 1u : 0u; mine = (j == x) ? c : mine; }
        if (sum == G) break;
        __builtin_amdgcn_s_sleep(1);
        if ((++sp & 255u) == 0u) { if (xb_ld(&bar[XB_TMO])) break; if (sp > XB_SPIN_CAP) { atomicAdd(&bar[XB_TMO], 1u); break; } }
    }
    nloc = mine > 0u ? mine : 1u; nx = cnt > 0u ? cnt : 1u;
}
__device__ __forceinline__ void xcd_barrier(const XcdBarrier& b, const int tid) {
    asm volatile("s_waitcnt vmcnt(0)" ::: "memory");
    __syncthreads();
    if (tid == 0) {
        unsigned* bar = b.bar;
        __builtin_amdgcn_s_waitcnt(0);
        unsigned nloc = b.st[0], nx = b.st[1];
        if (nloc == 0u) { xcd_barrier_complete(bar, b.x, nloc, nx); b.st[0] = nloc; b.st[1] = nx; }
        const unsigned old = xb_add(&bar[XB_XSUB(b.x)], 1u);
        const unsigned gen = old / nloc;
        if (old + 1u == (gen + 1u) * nloc) {
            __builtin_amdgcn_fence(__ATOMIC_RELEASE, "agent");
            asm volatile("s_waitcnt vmcnt(0)" ::: "memory");
            const unsigned og = xb_add(&bar[XB_TOP], 1u);
            const unsigned tg = og / nx;
            if (og + 1u == (tg + 1u) * nx) xb_add(&bar[XB_TOPGEN], 1u);
            else XB_SPIN(xb_ld(&bar[XB_TOPGEN]) == tg, bar);
            __builtin_amdgcn_fence(__ATOMIC_ACQUIRE, "agent");
            xb_add(&bar[XB_XGEN(b.x)], 1u);
            asm volatile("s_waitcnt vmcnt(0)" ::: "memory");
        } else {
            XB_SPIN(xb_ld(&bar[XB_XGEN(b.x)]) == gen, bar);
            __builtin_amdgcn_fence(__ATOMIC_ACQUIRE, "agent");
            asm volatile("s_waitcnt vmcnt(0)" ::: "memory");
        }
    }
    __syncthreads();
}

__global__ void __launch_bounds__(NTHR, 2) hybrid_fwd(Params Pv) {
    extern __shared__ __attribute__((aligned(16))) unsigned char lds_raw[];
    LAS unsigned char* lds = (LAS unsigned char*)lds_raw;
    cg::grid_group grid = cg::this_grid();
    KP P;
    { unsigned long long kb = (unsigned long long)__builtin_amdgcn_kernarg_segment_ptr(); asm volatile("" : "+s"(kb)); P = (KP)kb; }
    const int bx = blockIdx.x;
    const int wave0 = __builtin_amdgcn_readfirstlane(threadIdx.x >> 6);
    volatile LAS unsigned* bst = (volatile LAS unsigned*)(lds + 131072 + 1024);
    if (threadIdx.x < 4) bst[threadIdx.x] = 0u;
    __syncthreads();
    XcdBarrier xbar; xbar.bar = (unsigned*)(Pv.ws + WS_CTL); xbar.x = xb_xcc_id(); xbar.st = bst;
    if (threadIdx.x == 0) (void)xb_add(&xbar.bar[XB_XCNT(xbar.x)], 1u);

    {
    int G = gridDim.x; asm volatile("" : "+s"(G)); const int NGW = G * NWAVES;
    int tid = wave0 * 64 + (int)__builtin_amdgcn_mbcnt_hi(~0u, __builtin_amdgcn_mbcnt_lo(~0u, 0u)); asm volatile("" : "+v"(tid));
    const int lane = tid & 63, wave = __builtin_amdgcn_readfirstlane(tid >> 6), gw = bx * NWAVES + wave;
    bf16_t* const hb = (bf16_t*)(P->ws + WS_HB);
#if !defined(ONLY) || ONLY==0
    convert_weights(P, 0, lds, gw, NGW, wave, lane);
#endif
    {
        const f32x4* xs = (const f32x4*)P->in[I_X];
        for (size_t i = (size_t)bx * NTHR + tid; i < (size_t)NTOK * DM / 4; i += (size_t)G * NTHR) {
            const f32x4 v = xs[i]; ((f32x4*)P->out)[i] = v; u32x2 w; w.x = pk2(v.x, v.y); w.y = pk2(v.z, v.w); ((u32x2*)hb)[i] = w;
        }
        const f32x4* ms = (const f32x4*)P->in[I_MEM];
        for (size_t i = (size_t)bx * NTHR + tid; i < (size_t)512 * 1024 / 4; i += (size_t)G * NTHR) {
            const f32x4 v = ms[i]; u32x2 w; w.x = pk2(v.x, v.y); w.y = pk2(v.z, v.w); ((u32x2*)(P->ws + WS_MEMB))[i] = w;
        }
    }
    }
    grid.sync();

#pragma nounroll
    for (int ph = 0; ph < 30; ++ph) {
        const int layer = ph / 15, lp = ph % 15;
        { unsigned long long kb = (unsigned long long)__builtin_amdgcn_kernarg_segment_ptr(); asm volatile("" : "+s"(kb)); P = (KP)kb; }
        int G = gridDim.x; asm volatile("" : "+s"(G)); const int NGW = G * NWAVES;
        int tid = wave0 * 64 + (int)__builtin_amdgcn_mbcnt_hi(~0u, __builtin_amdgcn_mbcnt_lo(~0u, 0u)); asm volatile("" : "+v"(tid));
        bf16_t* const W = (bf16_t*)(P->ws + WS_W);
        bf16_t* const hb = (bf16_t*)(P->ws + WS_HB);
        pg8::Sched S; pg8::Epi E;
        S.mode = 0; S.G = G; S.c = bx; S.base = 0; S.nunits = 0; S.A = nullptr; S.B = nullptr; S.tA = 0; S.tB = 0; S.ws = (const char*)P->ws;
        E.mode = 0; E.ws = P->ws; E.o32 = P->out; E.gb = nullptr; E.o16off = 0; E.ldo = 0; E.scale = 1.f; E.act = 0;
        int lda = 1024, ldb = 1024, K = 1024; bool is_gemm = true;
        const size_t T1K = (size_t)256 * 1024 * 2;
        switch (lp) {
        case 0:
            S.mode = 1; S.nunits = 656; S.A = (const char*)hb; S.B = (const char*)(W + WO_IN); S.tA = T1K; S.tB = T1K;
            E.mode = 0;
            break;
        case 3:
            S.nunits = 64; S.A = (const char*)(P->ws + WS_YS5); S.B = (const char*)(W + WO_GLU); S.tA = (size_t)256 * 256 * 2; S.tB = (size_t)256 * 256 * 2; lda = 256; ldb = 256; K = 256;
            E.mode = 4; E.gb = P->in[I_GLUB] + layer * 256;
            break;
        case 5:
            S.nunits = 256; S.A = (const char*)(P->ws + WS_Y); S.B = (const char*)(W + WO_OUT); S.tA = T1K; S.tB = T1K;
            E.mode = 1;
            break;
        case 7:
            S.nunits = 256; S.A = (const char*)hb; S.B = (const char*)(W + WO_Q); S.tA = T1K; S.tB = T1K;
            E.mode = 2; E.o16off = WS_Q; E.ldo = 1024; E.scale = 0.0625f; E.act = 0;
            break;
        case 9:
            S.mode = 3; S.nunits = 256; S.A = (const char*)(P->ws + WS_P); S.B = (const char*)(P->ws + WS_VT); lda = 256; ldb = 256; K = 256;
            E.mode = 3;
            break;
        case 10:
            S.nunits = 256; S.A = (const char*)(P->ws + WS_AO); S.B = (const char*)(W + WO_O); S.tA = T1K; S.tB = T1K;
            E.mode = 1;
            break;
        case 12:
            S.nunits = 1024; S.A = (const char*)hb; S.B = (const char*)(W + WO_W1); S.tA = T1K; S.tB = T1K;
            E.mode = 2; E.o16off = WS_HID; E.ldo = 4096; E.act = 1;
            break;
        case 13:
            S.nunits = 256; S.A = (const char*)(P->ws + WS_HID); S.B = (const char*)(W + WO_W2); S.tA = (size_t)256 * 4096 * 2; S.tB = (size_t)256 * 4096 * 2; lda = 4096; ldb = 4096; K = 4096;
            E.mode = 1;
            break;
        default: is_gemm = false; break;
        }
#if !defined(ONLY) || ONLY==1
        if (is_gemm) pg8::gemm_phase<pg8::Epi, true, true>(lds, lda, ldb, K, S, E, tid);
#endif

        asm volatile("" : "+v"(tid));
        const int lane = tid & 63, wave = __builtin_amdgcn_readfirstlane(tid >> 6), gw = bx * NWAVES + wave;
        LAS unsigned char* wlds = lds + wave * 4608;
        switch (lp) {
        case 1: {
#if !defined(ONLY) || ONLY==2
            for (int u = bx; u < 512; u += G) ssd_prep_unit(P, layer, u >> 2, u & 3, lds, tid);
#endif
#if !defined(ONLY) || ONLY==3
            for (int u = bx; u < 256; u += G) rg_local_unit(P, layer, u, lds, tid);
#endif
#if !defined(ONLY) || ONLY==4
            for (int it = gw; it < 2048; it += NGW) s5_end_item(P, layer, it, lane);
#endif
        } break;
        case 2: {
#if !defined(ONLY) || ONLY==5
            for (int it = gw; it < 2048; it += NGW) ssd_states_item(P, it, wlds, lane);
#endif
#if !defined(ONLY) || ONLY==6
            for (int it = gw; it < 2048; it += NGW) s5_final_item(P, layer, it, wlds, lane);
#endif
        } break;
        case 3: {
            __syncthreads();
#if !defined(ONLY) || ONLY==7
            for (int u = bx; u < 256; u += G) rg_final_unit(P, u, lds, tid);
#endif
            for (int it = (G > 128 ? (bx >= 64 ? (bx - 64) * NWAVES + wave : 1 << 30) : gw); it < 256; it += NGW) ssd_scan_item(P, it, lane);
        } break;
        case 4: {
#if !defined(ONLY) || ONLY==8
            for (int it = gw; it < 1024; it += NGW) ssd_final_item(P, layer, it, wlds, lane);
#endif
        } break;
        case 6: ln_rows(P, P->in[I_LN1G] + layer * 1024, P->in[I_LN1B] + layer * 1024, gw, NGW, lane); break;
        case 8: {
            pg8::Sched S2 = S; S2.mode = 2; S2.nunits = 256; S2.A = (const char*)(P->ws + WS_Q); S2.B = (const char*)(P->ws + WS_KB);
            pg8::EpiSoftmax E2; E2.P = (bf16_t*)(P->ws + WS_P);
#if !defined(ONLY) || ONLY==9
            for (int base = 0; base < 256; base += G) { S2.base = base; S2.nunits = (base + G < 256) ? base + G : 256; int tid2 = tid; asm volatile("" : "+v"(tid2)); pg8::gemm_phase<pg8::EpiSoftmax, false, true>(lds, 1024, 1024, 256, S2, E2, tid2); __syncthreads(); }
#endif
        } break;
        case 11: ln_rows(P, P->in[I_LN2G] + layer * 1024, P->in[I_LN2B] + layer * 1024, gw, NGW, lane); break;
        case 14: {
            ln_rows(P, P->in[I_LN3G] + layer * 1024, P->in[I_LN3B] + layer * 1024, gw, NGW, lane);
            if (layer == 0) { __syncthreads(); convert_weights(P, 1, lds, gw, NGW, wave, lane); }
        } break;
        default: break;
        }
        if (ph != 29) xcd_barrier(xbar, tid);
    }
}

extern "C" void kernel_launch(void* const* d_in, const int* in_sizes, int n_in, void* d_out, int out_size, void* d_ws, size_t ws_size, hipStream_t stream) {
    static int grid = 0;
    if (grid == 0) {
        if (n_in != 39 || out_size != NTOK * DM || ws_size < WS_END) { fprintf(stderr, "kernel_launch: unexpected shapes (n_in %d out %d ws %zu)\n", n_in, out_size, ws_size); grid = -1; return; }
        int dev = 0, cus = 0, per_cu = 0;
        hipGetDevice(&dev);
        hipDeviceGetAttribute(&cus, hipDeviceAttributeMultiprocessorCount, dev);
        if (hipFuncSetAttribute((const void*)hybrid_fwd, hipFuncAttributeMaxDynamicSharedMemorySize, LDS_BYTES) != hipSuccess) { fprintf(stderr, "kernel_launch: hipFuncSetAttribute failed\n"); grid = -1; return; }
        if (hipOccupancyMaxActiveBlocksPerMultiprocessor(&per_cu, (const void*)hybrid_fwd, NTHR, LDS_BYTES) != hipSuccess || per_cu < 1) { fprintf(stderr, "kernel_launch: occupancy query says %d\n", per_cu); per_cu = 1; }
        (void)hipGetLastError();
        grid = cus;
        if (grid > 256) grid = 256;
    }
    if (grid < 0) return;
    if (hipMemsetAsync((char*)d_ws + WS_CTL, 0, 16384, stream) != hipSuccess) { fprintf(stderr, "kernel_launch: memset failed\n"); return; }
    Params p{};
    for (int i = 0; i < 39; ++i) p.in[i] = (const float*)d_in[i];
    p.out = (float*)d_out; p.ws = (unsigned char*)d_ws;
    void* args[] = {&p};
    hipError_t e = hipLaunchCooperativeKernel((const void*)hybrid_fwd, dim3(grid), dim3(NTHR), args, LDS_BYTES, stream);
    if (e != hipSuccess) fprintf(stderr, "cooperative launch failed: %s (grid %d)\n", hipGetErrorString(e), grid);
}
```
